# Optimizing an MI355X kernel written in HIP

```python
import math
import jax, jax.numpy as jnp
from jax import lax
import numpy as np

D_MODEL = 1024
BATCH = 16
SEQ = 2048
DEPTH = 1

CHUNK = 64
N_Q_HEADS = 8
N_KV_HEADS = 2
HEAD_DIM = 64
Q_REP = N_Q_HEADS // N_KV_HEADS
ATTN_WIDTH = N_Q_HEADS * HEAD_DIM
KV_WIDTH = N_KV_HEADS * HEAD_DIM
WINDOW = 128
WINDOW_CHUNKS = WINDOW // CHUNK
BAND = (WINDOW_CHUNKS + 1) * CHUNK
ROPE_THETA = 500000.0
ROT_DIM = HEAD_DIM // 4
SSM_WIDTH = D_MODEL - ATTN_WIDTH
SSM_GROUP = 16
N_SSM_GROUPS = SSM_WIDTH // SSM_GROUP
SSM_STATE = 64
MIX_WIDTH = ATTN_WIDTH + SSM_WIDTH
IN_WIDTH = ATTN_WIDTH + 2 * KV_WIDTH + SSM_WIDTH
D_FF = -(-8 * D_MODEL // (3 * 256)) * 256
PLE_DIM = 256
EPS = 1e-6
DT_MIN = 1e-3
DT_MAX = 1e-1
LAMBDA_RE_MAX = -1e-4
NEG_INF = -1e30

kernel_name = "hymba_swa_sink_s5_swiglu_ple"

F32 = jnp.float32


def rms_norm(t, g):
    tf = t.astype(F32)
    y = tf * lax.rsqrt(jnp.mean(tf * tf, axis=-1, keepdims=True) + EPS)
    return (y * g.astype(F32)).astype(t.dtype)


def partial_rotary(t, positions):
    half = ROT_DIM // 2
    inv_freq = ROPE_THETA ** (-jnp.arange(half, dtype=F32) * (2.0 / ROT_DIM))
    ang = positions.astype(F32)[..., None] * inv_freq
    cos = jnp.cos(ang)[:, :, None, :]
    sin = jnp.sin(ang)[:, :, None, :]
    tr = t[..., :ROT_DIM].astype(F32)
    t1, t2 = tr[..., :half], tr[..., half:]
    rot = jnp.concatenate([t1 * cos - t2 * sin, t1 * sin + t2 * cos], axis=-1).astype(t.dtype)
    return jnp.concatenate([rot, t[..., ROT_DIM:]], axis=-1)


def sliding_window_attention(q, k, v, sinks):
    B, L = q.shape[0], q.shape[1]
    nc = L // CHUNK
    qc = q.reshape(B, nc, CHUNK, N_KV_HEADS, Q_REP, HEAD_DIM)

    def band(t):
        tc = t.reshape(B, nc, CHUNK, N_KV_HEADS, HEAD_DIM)
        tp = jnp.pad(tc, ((0, 0), (WINDOW_CHUNKS, 0), (0, 0), (0, 0), (0, 0)))
        return jnp.concatenate([tp[:, i:i + nc] for i in range(WINDOW_CHUNKS + 1)], axis=2)

    kb = band(k)
    vb = band(v)
    scores = jnp.einsum('bcqhgd,bcjhd->bchgqj', qc, kb,
                        preferred_element_type=F32) * (HEAD_DIM ** -0.5)
    key_chunk = (jnp.arange(nc)[:, None] - WINDOW_CHUNKS
                 + jnp.arange(BAND)[None, :] // CHUNK)
    valid = (key_chunk >= 0)[None, :, None, None, None, :]
    scores = jnp.where(valid, scores, NEG_INF)
    sink = sinks.astype(F32).reshape(N_KV_HEADS, Q_REP)[None, None, :, :, None, None]
    m = jnp.maximum(jnp.max(scores, axis=-1, keepdims=True), sink)
    pr = jnp.exp(scores - m)
    denom = jnp.sum(pr, axis=-1, keepdims=True) + jnp.exp(sink - m)
    w = (pr / denom).astype(v.dtype)
    out = jnp.einsum('bchgqj,bcjhd->bcqhgd', w, vb)
    return out.reshape(B, L, ATTN_WIDTH)


def s5_ssm(u, lam_re, lam_im, b_re, b_im, c_re, c_im, d_skip, log_dt, glu_w, glu_b):
    Bsz, L = u.shape[0], u.shape[1]
    uf = u.astype(F32).reshape(Bsz, L, N_SSM_GROUPS, SSM_GROUP)
    lr = jnp.minimum(lam_re.astype(F32), LAMBDA_RE_MAX)
    li = lam_im.astype(F32)
    dt = jnp.exp(log_dt.astype(F32))[:, None]
    mag = jnp.exp(lr * dt)
    ab_re = mag * jnp.cos(li * dt)
    ab_im = mag * jnp.sin(li * dt)
    nr = ab_re - 1.0
    ni = ab_im
    den = lr * lr + li * li
    f_re = (nr * lr + ni * li) / den
    f_im = (ni * lr - nr * li) / den
    br = b_re.astype(F32)
    bi = b_im.astype(F32)
    bb_re = f_re[..., None] * br - f_im[..., None] * bi
    bb_im = f_re[..., None] * bi + f_im[..., None] * br
    bu_re = jnp.einsum('blgc,gnc->blgn', uf, bb_re)
    bu_im = jnp.einsum('blgc,gnc->blgn', uf, bb_im)
    a_re = jnp.broadcast_to(ab_re, (1, L, N_SSM_GROUPS, SSM_STATE))
    a_im = jnp.broadcast_to(ab_im, (1, L, N_SSM_GROUPS, SSM_STATE))

    def combine(e1, e2):
        a1r, a1i, b1r, b1i = e1
        a2r, a2i, b2r, b2i = e2
        return (a2r * a1r - a2i * a1i,
                a2r * a1i + a2i * a1r,
                a2r * b1r - a2i * b1i + b2r,
                a2r * b1i + a2i * b1r + b2i)

    _, _, s_re, s_im = lax.associative_scan(combine, (a_re, a_im, bu_re, bu_im), axis=1)
    y = (jnp.einsum('blgn,gcn->blgc', s_re, c_re.astype(F32))
         - jnp.einsum('blgn,gcn->blgc', s_im, c_im.astype(F32))
         + d_skip.astype(F32) * uf)
    y = jax.nn.gelu(y.reshape(Bsz, L, SSM_WIDTH)).astype(u.dtype)
    return y * jax.nn.sigmoid(y @ glu_w + glu_b)


def setup_inputs(seed: int = 0) -> dict:
    key = jax.random.key(seed)
    ks = jax.random.split(key, 32)
    nrm = jax.random.normal
    x = nrm(ks[0], (BATCH, SEQ, D_MODEL), F32)
    p = nrm(ks[1], (DEPTH, BATCH, SEQ, PLE_DIM), F32)
    offset = jax.random.randint(ks[2], (BATCH, 1), 0, 8192)
    positions = (offset + jnp.arange(SEQ)[None, :]).astype(jnp.int32)
    G, N = N_SSM_GROUPS, SSM_STATE
    return {
        "x": x,
        "p": p,
        "positions": positions,
        "norm1_g": 1.0 + 0.02 * nrm(ks[3], (DEPTH, D_MODEL), F32),
        "w_in": nrm(ks[4], (DEPTH, D_MODEL, IN_WIDTH), F32) * D_MODEL ** -0.5,
        "q_norm_g": 1.0 + 0.02 * nrm(ks[5], (DEPTH, HEAD_DIM), F32),
        "k_norm_g": 1.0 + 0.02 * nrm(ks[6], (DEPTH, HEAD_DIM), F32),
        "attn_sinks": 0.5 * nrm(ks[7], (DEPTH, N_Q_HEADS), F32),
        "ssm_lambda_re": -0.5 + 0.01 * nrm(ks[8], (DEPTH, G, N), F32),
        "ssm_lambda_im": math.pi * jnp.arange(N, dtype=F32)[None, None, :]
                         + 0.01 * nrm(ks[9], (DEPTH, G, N), F32),
        "ssm_b_re": nrm(ks[10], (DEPTH, G, N, SSM_GROUP), F32) * (2.0 * SSM_GROUP) ** -0.5,
        "ssm_b_im": nrm(ks[11], (DEPTH, G, N, SSM_GROUP), F32) * (2.0 * SSM_GROUP) ** -0.5,
        "ssm_c_re": nrm(ks[12], (DEPTH, G, SSM_GROUP, N), F32) * (2.0 * N) ** -0.5,
        "ssm_c_im": nrm(ks[13], (DEPTH, G, SSM_GROUP, N), F32) * (2.0 * N) ** -0.5,
        "ssm_d": nrm(ks[14], (DEPTH, G, SSM_GROUP), F32),
        "ssm_log_dt": jax.random.uniform(ks[15], (DEPTH, G), F32,
                                         minval=math.log(DT_MIN), maxval=math.log(DT_MAX)),
        "glu_w": nrm(ks[16], (DEPTH, SSM_WIDTH, SSM_WIDTH), F32) * SSM_WIDTH ** -0.5,
        "glu_b": 0.01 * nrm(ks[17], (DEPTH, SSM_WIDTH), F32),
        "attn_out_norm_g": 1.0 + 0.02 * nrm(ks[18], (DEPTH, ATTN_WIDTH), F32),
        "ssm_out_norm_g": 1.0 + 0.02 * nrm(ks[19], (DEPTH, SSM_WIDTH), F32),
        "w_out": nrm(ks[20], (DEPTH, MIX_WIDTH, D_MODEL), F32) * MIX_WIDTH ** -0.5,
        "norm2_g": 1.0 + 0.02 * nrm(ks[21], (DEPTH, D_MODEL), F32),
        "w_ffn_gate": nrm(ks[22], (DEPTH, D_MODEL, D_FF), F32) * D_MODEL ** -0.5,
        "w_ffn_up": nrm(ks[23], (DEPTH, D_MODEL, D_FF), F32) * D_MODEL ** -0.5,
        "w_ffn_down": nrm(ks[24], (DEPTH, D_FF, D_MODEL), F32) * D_FF ** -0.5,
        "ple_norm_g": 1.0 + 0.02 * nrm(ks[25], (DEPTH, D_MODEL), F32),
        "w_ple_gate": nrm(ks[26], (DEPTH, D_MODEL, D_MODEL), F32) * D_MODEL ** -0.5,
        "b_ple_gate": 0.01 * nrm(ks[27], (DEPTH, D_MODEL), F32),
        "w_ple_proj": nrm(ks[28], (DEPTH, PLE_DIM, D_MODEL), F32) * PLE_DIM ** -0.5,
    }


def reference(x, p, positions, norm1_g, w_in, q_norm_g, k_norm_g, attn_sinks,
              ssm_lambda_re, ssm_lambda_im, ssm_b_re, ssm_b_im, ssm_c_re, ssm_c_im,
              ssm_d, ssm_log_dt, glu_w, glu_b, attn_out_norm_g, ssm_out_norm_g, w_out,
              norm2_g, w_ffn_gate, w_ffn_up, w_ffn_down, ple_norm_g, w_ple_gate,
              b_ple_gate, w_ple_proj):
    B, L = x.shape[0], x.shape[1]
    h = x
    for i in range(DEPTH):
        hn = rms_norm(h, norm1_g[i])
        z = hn @ w_in[i]
        q = z[..., :ATTN_WIDTH].reshape(B, L, N_Q_HEADS, HEAD_DIM)
        k = z[..., ATTN_WIDTH:ATTN_WIDTH + KV_WIDTH].reshape(B, L, N_KV_HEADS, HEAD_DIM)
        v = z[..., ATTN_WIDTH + KV_WIDTH:ATTN_WIDTH + 2 * KV_WIDTH].reshape(B, L, N_KV_HEADS, HEAD_DIM)
        u = z[..., ATTN_WIDTH + 2 * KV_WIDTH:]
        q = partial_rotary(rms_norm(q, q_norm_g[i]), positions)
        k = partial_rotary(rms_norm(k, k_norm_g[i]), positions)
        a_out = sliding_window_attention(q, k, v, attn_sinks[i])
        s_out = s5_ssm(u, ssm_lambda_re[i], ssm_lambda_im[i], ssm_b_re[i], ssm_b_im[i],
                       ssm_c_re[i], ssm_c_im[i], ssm_d[i], ssm_log_dt[i], glu_w[i], glu_b[i])
        mix = jnp.concatenate([rms_norm(a_out, attn_out_norm_g[i]),
                               rms_norm(s_out, ssm_out_norm_g[i])], axis=-1)
        h = h + mix @ w_out[i]
        hn2 = rms_norm(h, norm2_g[i])
        h = h + (jax.nn.silu(hn2 @ w_ffn_gate[i]) * (hn2 @ w_ffn_up[i])) @ w_ffn_down[i]
        gate = jax.nn.sigmoid(rms_norm(h, ple_norm_g[i]) @ w_ple_gate[i] + b_ple_gate[i])
        h = h + gate * (p[i] @ w_ple_proj[i])
    return h
```

```cpp
#include <hip/hip_runtime.h>
#include <hip/hip_cooperative_groups.h>
#include <cstdio>
#include <cstdint>
namespace cg = cooperative_groups;

#ifndef MK_N_LAUNCHES
#define MK_N_LAUNCHES 8
#endif
#ifndef MK_BARRIER
#define MK_BARRIER 0
#endif

namespace pg8 {
#define PG8_LAS __attribute__((address_space(3)))
typedef unsigned short bf16_t;
typedef short bf16x8 __attribute__((ext_vector_type(8)));
typedef float f32x4 __attribute__((ext_vector_type(4)));
typedef unsigned u32x4 __attribute__((ext_vector_type(4)));
constexpr int BM = 256, BK = 64, HALF = 128, HTB = HALF * BK * 2  , STAGE_BYTES = 8 * HTB, NXCD = 8, WGM = 8;

__host__ __device__ __forceinline__ int lds_byte(int r, int c) { const int st = (r >> 4) * 2 + (c >> 5), rr = r & 15, cc = c & 31, ob = rr * 64 + cc * 2; return st * 1024 + (ob ^ (((ob >> 9) & 1) << 5)); }
__host__ __device__ __forceinline__ void stage_rc(int b, int& R, int& C) { const int st = b / 1024, sb = b % 1024, swz = sb ^ (((sb >> 9) & 1) << 5); R = (st >> 1) * 16 + swz / 64; C = (st & 1) * 32 + (swz % 64) / 2; }
__host__ __device__ __forceinline__ int perm32(int rho) { const int n = rho >> 4, i = rho & 15; return 8 * (i >> 2) + 4 * n + (i & 3); }

struct Unit { int pm, pn; };
struct Gemm { const bf16_t* A; const bf16_t* Bt; int M, N, K; };

struct StaticOrder {
    int nM, nN, nwg, G, c;
    __host__ __device__ void init(int M, int N, int G_, int c_) { nM = M / BM; nN = N / BM; nwg = nM * nN; G = G_; c = c_; }
    __host__ __device__ bool next(int i, Unit& u) const {
        const long L = (long)i * G + c; if (L >= nwg) return false;
        int wgid = (int)L; { const int q = nwg / NXCD, r = nwg % NXCD, xcd = wgid % NXCD, off = wgid / NXCD; wgid = (xcd < r ? xcd * (q + 1) : r * (q + 1) + (xcd - r) * q) + off; }
        const int nig = WGM * nN, gid = wgid / nig, fm = gid * WGM, gsz = (nM - fm) < WGM ? (nM - fm) : WGM;
        u.pm = fm + ((wgid % nig) % gsz); u.pn = (wgid % nig) / gsz; return true;
    }
    __device__ __forceinline__ void a_ready(const Unit&) const {}
    __device__ __forceinline__ void done(const Unit&) const {}
};

__device__ __forceinline__ unsigned cvt_pk_bf16(float lo, float hi) { unsigned r; asm volatile("v_cvt_pk_bf16_f32 %0, %1, %2" : "=v"(r) : "v"(lo), "v"(hi)); return r; }
typedef float f32x2 __attribute__((ext_vector_type(2)));
template <class Epi, class Sched, bool ALIGN_EPI = false, bool SP2 = false>
__device__ __forceinline__ void gemm_phase(PG8_LAS unsigned char* lds, const Gemm g, const Sched& S, const Epi& E) {
    const int tid = threadIdx.x, wid = __builtin_amdgcn_readfirstlane(tid >> 6), lane = tid & 63, wr = wid >> 2, wc = wid & 3, fr = lane & 15, fq = lane >> 4;
    int K_ = g.K; asm volatile("" : "+s"(K_));
    const int K = K_, nt = K / BK;
    unsigned voffA[2], voffB[2];
#pragma unroll
    for (int i = 0; i < 2; ++i) { int R, C; stage_rc(tid * 16 + i * 8192, R, C); const int Rb = Epi::PERM ? ((R & ~31) + perm32(R & 31)) : R;
        voffA[i] = (unsigned)(R * K + C) * 2u; voffB[i] = (unsigned)(Rb * K + C) * 2u; }
    const size_t kstep = (size_t)(BK * 2);
    const size_t hstep = (size_t)HALF * K * 2;
    const size_t tstep = 2 * hstep;
    const unsigned ldsw = (unsigned)wid * 1024u;
    const int aoff = lds_byte(wr * 64 + fr, fq * 8), boff = lds_byte(wc * 32 + fr, fq * 8);
#define PG8_SA(b, h) (((b) * 2 + (h)) * HTB)
#define PG8_SB(b, h) ((4 + (b) * 2 + (h)) * HTB)
#define PG8_STAGE(bufoff, gbase, voff) do { _Pragma("unroll") for (int _i = 0; _i < 2; ++_i) \
        __builtin_amdgcn_global_load_lds((const unsigned*)((const char*)(gbase) + (voff)[_i]), (PG8_LAS unsigned*)(lds + (bufoff) + ldsw + _i * 8192), 16, 0, 0); } while (0)
#define PG8_LDA(dst, b, h) do { _Pragma("unroll") for (int m = 0; m < 4; ++m) _Pragma("unroll") for (int k = 0; k < 2; ++k) dst[m][k] = *(const PG8_LAS bf16x8*)(lds + PG8_SA(b, h) + aoff + m * 2048 + k * 1024); } while (0)
#define PG8_LDB(dst, b, h) do { _Pragma("unroll") for (int n = 0; n < 2; ++n) _Pragma("unroll") for (int k = 0; k < 2; ++k) dst[n][k] = *(const PG8_LAS bf16x8*)(lds + PG8_SB(b, h) + boff + n * 2048 + k * 1024); } while (0)
#define PG8_MMA(ai, bj, At, Bt) do { __builtin_amdgcn_s_setprio(1); _Pragma("unroll") for (int m = 0; m < 4; ++m) _Pragma("unroll") for (int n = 0; n < 2; ++n) _Pragma("unroll") for (int k = 0; k < 2; ++k) \
        acc[ai][bj][m][n] = __builtin_amdgcn_mfma_f32_16x16x32_bf16(Bt[n][k], At[m][k], acc[ai][bj][m][n], 0, 0, 0); __builtin_amdgcn_s_setprio(0); } while (0)
#define PG8_WAIT_V(n) asm volatile("s_waitcnt vmcnt(" #n ")" ::: "memory")
#define PG8_WAIT_L(n) asm volatile("s_waitcnt lgkmcnt(" #n ")" ::: "memory")
#define PG8_BAR __builtin_amdgcn_s_barrier()
#define PG8_SCHED __builtin_amdgcn_sched_barrier(0)
    Unit cur, nxt; int ui = 0;
    if (!S.next(0, cur)) return;
    f32x4 acc[2][2][4][2];
#pragma unroll
    for (int a = 0; a < 2; ++a)
#pragma unroll
        for (int b = 0; b < 2; ++b)
#pragma unroll
            for (int m = 0; m < 4; ++m)
#pragma unroll
                for (int n = 0; n < 2; ++n) acc[a][b][m][n] = (f32x4){0.f, 0.f, 0.f, 0.f};
    bf16x8 At[4][2], B0[2][2], B1[2][2];
    const char* cA = (const char*)g.A + (size_t)cur.pm * tstep; const char* cB = (const char*)g.Bt + (size_t)cur.pn * tstep;
    S.a_ready(cur);
    if constexpr (SP2) {
        PG8_STAGE(PG8_SB(0, 0), cB, voffB); PG8_STAGE(PG8_SB(0, 1), cB + hstep, voffB); PG8_STAGE(PG8_SA(0, 0), cA, voffA); PG8_STAGE(PG8_SA(0, 1), cA + hstep, voffA);
        if (wr == 1) PG8_BAR;
        PG8_WAIT_V(2); PG8_BAR;
        PG8_STAGE(PG8_SB(1, 0), cB + kstep, voffB); PG8_STAGE(PG8_SA(1, 0), cA + kstep, voffA); PG8_STAGE(PG8_SB(1, 1), cB + hstep + kstep, voffB);
        PG8_WAIT_V(6); PG8_BAR;
    } else {
        PG8_STAGE(PG8_SB(0, 0), cB, voffB); PG8_STAGE(PG8_SA(0, 0), cA, voffA); PG8_STAGE(PG8_SB(0, 1), cB + hstep, voffB); PG8_STAGE(PG8_SA(0, 1), cA + hstep, voffA);
        if (wr == 1) PG8_BAR;
        PG8_WAIT_V(4); PG8_BAR;
        PG8_STAGE(PG8_SB(1, 0), cB + kstep, voffB); PG8_STAGE(PG8_SA(1, 0), cA + kstep, voffA); PG8_STAGE(PG8_SB(1, 1), cB + hstep + kstep, voffB);
        PG8_WAIT_V(6); PG8_BAR;
    }
    for (;;) {
        const bool has_next = S.next(ui + 1, nxt);
        const char* nA = has_next ? (const char*)g.A + (size_t)nxt.pm * tstep : cA; const char* nB = has_next ? (const char*)g.Bt + (size_t)nxt.pn * tstep : cB;
        for (int t = 0; t < nt; t += 2) {
            const bool last = (t == nt - 2);
            if constexpr (Epi::MID_T >= 0) { if (t == Epi::MID_T) E.mid(acc, cur, wr, fr); }
            const char* a1 = cA + (size_t)(t + 1) * kstep;
            const char* a2 = last ? nA : cA + (size_t)(t + 2) * kstep; const char* b2 = last ? nB : cB + (size_t)(t + 2) * kstep;
            const char* a3 = a2 + kstep; const char* b3 = b2 + kstep;
            if (last && has_next) S.a_ready(nxt);
            if constexpr (SP2) {
            PG8_LDB(B0, 0, 0); PG8_LDB(B1, 0, 1); PG8_SCHED; PG8_LDA(At, 0, 0); PG8_STAGE(PG8_SA(1, 1), a1 + hstep, voffA);
            PG8_WAIT_V(8); PG8_WAIT_L(0); PG8_BAR; PG8_MMA(0, 0, At, B0); PG8_MMA(0, 1, At, B1); PG8_BAR; PG8_SCHED;
            PG8_LDA(At, 0, 1); PG8_STAGE(PG8_SB(0, 0), b2, voffB); PG8_STAGE(PG8_SB(0, 1), b2 + hstep, voffB); PG8_STAGE(PG8_SA(0, 0), a2, voffA);
            PG8_WAIT_V(8); PG8_WAIT_L(0); PG8_BAR; PG8_MMA(1, 0, At, B0); PG8_MMA(1, 1, At, B1); PG8_BAR; PG8_SCHED;
            PG8_LDB(B0, 1, 0); PG8_LDB(B1, 1, 1); PG8_SCHED; PG8_LDA(At, 1, 0); PG8_STAGE(PG8_SA(0, 1), a2 + hstep, voffA);
            PG8_WAIT_V(8); PG8_WAIT_L(0); PG8_BAR; PG8_MMA(0, 0, At, B0); PG8_MMA(0, 1, At, B1); PG8_BAR; PG8_SCHED;
            PG8_LDA(At, 1, 1); PG8_STAGE(PG8_SB(1, 0), b3, voffB); PG8_STAGE(PG8_SB(1, 1), b3 + hstep, voffB); PG8_STAGE(PG8_SA(1, 0), a3, voffA);
            PG8_WAIT_V(8); PG8_WAIT_L(0); PG8_BAR; PG8_MMA(1, 0, At, B0); PG8_MMA(1, 1, At, B1); PG8_BAR; PG8_SCHED;
            } else {
            PG8_LDB(B0, 0, 0); PG8_SCHED; PG8_LDA(At, 0, 0); PG8_STAGE(PG8_SA(1, 1), a1 + hstep, voffA);
            PG8_WAIT_L(8); PG8_BAR; PG8_WAIT_L(0); PG8_MMA(0, 0, At, B0); PG8_BAR; PG8_SCHED;
            PG8_LDB(B1, 0, 1); PG8_STAGE(PG8_SB(0, 0), b2, voffB);
            PG8_BAR; PG8_WAIT_L(0); PG8_MMA(0, 1, At, B1); PG8_BAR;
            PG8_LDA(At, 0, 1); PG8_STAGE(PG8_SA(0, 0), a2, voffA);
            PG8_BAR; PG8_WAIT_L(0); PG8_MMA(1, 0, At, B0); PG8_BAR; PG8_SCHED;
            PG8_STAGE(PG8_SB(0, 1), b2 + hstep, voffB);
            PG8_WAIT_V(6); PG8_BAR; PG8_MMA(1, 1, At, B1); PG8_BAR;
            PG8_LDB(B0, 1, 0); PG8_SCHED; PG8_LDA(At, 1, 0); PG8_STAGE(PG8_SA(0, 1), a2 + hstep, voffA);
            PG8_WAIT_L(8); PG8_BAR; PG8_WAIT_L(0); PG8_MMA(0, 0, At, B0); PG8_BAR; PG8_SCHED;
            PG8_LDB(B1, 1, 1); PG8_STAGE(PG8_SB(1, 0), b3, voffB);
            PG8_BAR; PG8_WAIT_L(0); PG8_MMA(0, 1, At, B1); PG8_BAR;
            PG8_LDA(At, 1, 1); PG8_STAGE(PG8_SA(1, 0), a3, voffA);
            PG8_BAR; PG8_WAIT_L(0); PG8_MMA(1, 0, At, B0); PG8_BAR; PG8_SCHED;
            PG8_STAGE(PG8_SB(1, 1), b3 + hstep, voffB);
            PG8_WAIT_V(6); PG8_BAR; PG8_MMA(1, 1, At, B1); PG8_BAR;
            }
        }
        if constexpr (ALIGN_EPI) { if (wr == 0) PG8_BAR; }
        if constexpr (!Epi::AFTER_DRAIN) { E(acc, cur, wr, wc, fr, fq); S.done(cur); }
        if (!has_next) break;
#pragma unroll
        for (int a = 0; a < 2; ++a)
#pragma unroll
            for (int b = 0; b < 2; ++b)
#pragma unroll
                for (int m = 0; m < 4; ++m)
#pragma unroll
                    for (int n = 0; n < 2; ++n) acc[a][b][m][n] = (f32x4){0.f, 0.f, 0.f, 0.f};
        cur = nxt; cA = nA; cB = nB; ++ui;
        if constexpr (ALIGN_EPI) { if (wr == 1) PG8_BAR; }
    }
    PG8_WAIT_V(0);
    if constexpr (!ALIGN_EPI) { if (wr == 0) PG8_BAR; }
    PG8_BAR;
    if constexpr (Epi::AFTER_DRAIN) { E.fused(acc, cur, wr, wc, fr, fq, lds, wid, lane); S.done(cur); }
#undef PG8_SA
#undef PG8_SB
#undef PG8_STAGE
#undef PG8_LDA
#undef PG8_LDB
#undef PG8_MMA
#undef PG8_WAIT_V
#undef PG8_WAIT_L
#undef PG8_BAR
#undef PG8_SCHED
}
}

#define GAS __attribute__((address_space(1)))
#define LAS __attribute__((address_space(3)))
typedef unsigned short bf16;
typedef unsigned v4u __attribute__((ext_vector_type(4)));
typedef float f32x4 __attribute__((ext_vector_type(4)));
typedef short bf16x8 __attribute__((ext_vector_type(8)));
typedef GAS unsigned gu32;
typedef GAS unsigned long long gu64;
#define RLX_AGENT __ATOMIC_RELAXED, __HIP_MEMORY_SCOPE_AGENT
#define LDS_WAIT() asm volatile("s_waitcnt lgkmcnt(0)" ::: "memory")
#define VM_WAIT() asm volatile("s_waitcnt vmcnt(0)" ::: "memory")
__device__ __forceinline__ unsigned long long rt() { return __builtin_amdgcn_s_memrealtime(); }

#define XB_TMO      128
#define XB_XCNT(j)  (256  + 64 * (j))
#define XB_XSUB(j)  (1280 + 64 * (j))
#define XB_XGEN(j)  (2304 + 64 * (j))
#define XB_TOP      3328
#define XB_TOPGEN   3392
#define XCD_BAR_WORDS 3456
#define XB_SPIN_CAP (1u << 18)

__device__ __forceinline__ unsigned xb_ld(unsigned* p)              { return __hip_atomic_load(p, __ATOMIC_RELAXED, __HIP_MEMORY_SCOPE_AGENT); }
__device__ __forceinline__ unsigned xb_add(unsigned* p, unsigned v) { return __hip_atomic_fetch_add(p, v, __ATOMIC_RELAXED, __HIP_MEMORY_SCOPE_AGENT); }
__device__ __forceinline__ unsigned xb_xcc_id() { return (unsigned)__builtin_amdgcn_s_getreg((3 << 11) | 20) & 0xFu; }
#define XB_SPIN(cond, bar) do { unsigned _sp = 0; while (cond) { __builtin_amdgcn_s_sleep(1); \
    if ((++_sp & 255u) == 0u) { if (xb_ld(&(bar)[XB_TMO])) break; if (_sp > XB_SPIN_CAP) { atomicAdd(&(bar)[XB_TMO], 1u); break; } } } } while (0)

struct XcdBarrier {
    unsigned* bar; unsigned x;
    volatile LAS unsigned* st;
};

__device__ __forceinline__ XcdBarrier xcd_barrier_post(unsigned* bar, volatile LAS unsigned* st) {
    XcdBarrier b; b.bar = bar; b.x = xb_xcc_id(); b.st = st;
    if (threadIdx.x == 0) (void)xb_add(&bar[XB_XCNT(b.x)], 1u);
    return b;
}
__device__ __forceinline__ void xcd_barrier_complete(unsigned* bar, unsigned x, unsigned& nloc, unsigned& nx) {
    const unsigned G = gridDim.x * gridDim.y * gridDim.z;
    unsigned sum, cnt, mine, sp = 0u;
    for (;;) {
        sum = 0u; cnt = 0u; mine = 0u;
#pragma unroll
        for (unsigned j = 0; j < 16; ++j) { const unsigned c = xb_ld(&bar[XB_XCNT(j)]); sum += c; cnt += (c > 0u) ? 1u : 0u; mine = (j == x) ? c : mine; }
        if (sum == G) break;
        __builtin_amdgcn_s_sleep(1);
        if ((++sp & 255u) == 0u) { if (xb_ld(&bar[XB_TMO])) break; if (sp > XB_SPIN_CAP) { atomicAdd(&bar[XB_TMO], 1u); break; } }
    }
    nloc = mine > 0u ? mine : 1u; nx = cnt > 0u ? cnt : 1u;
}

__device__ __forceinline__ void xcd_barrier(const XcdBarrier& b) {
    asm volatile("s_waitcnt vmcnt(0)" ::: "memory");
    __syncthreads();
    if (threadIdx.x == 0) {
        unsigned* bar = b.bar;
        __builtin_amdgcn_s_waitcnt(0);
        unsigned nloc = b.st[0], nx = b.st[1];
        if (nloc == 0u) { xcd_barrier_complete(bar, b.x, nloc, nx); b.st[0] = nloc; b.st[1] = nx; }
        const unsigned old = xb_add(&bar[XB_XSUB(b.x)], 1u);
        const unsigned gen = old / nloc;
        if (old + 1u == (gen + 1u) * nloc) {
            __builtin_amdgcn_fence(__ATOMIC_RELEASE, "agent");
            asm volatile("s_waitcnt vmcnt(0)" ::: "memory");
            const unsigned og = xb_add(&bar[XB_TOP], 1u);
            const unsigned tg = og / nx;
            if (og + 1u == (tg + 1u) * nx) xb_add(&bar[XB_TOPGEN], 1u);
            else XB_SPIN(xb_ld(&bar[XB_TOPGEN]) == tg, bar);
            __builtin_amdgcn_fence(__ATOMIC_ACQUIRE, "agent");
            xb_add(&bar[XB_XGEN(b.x)], 1u);
            asm volatile("s_waitcnt vmcnt(0)" ::: "memory");
        } else {
            XB_SPIN(xb_ld(&bar[XB_XGEN(b.x)]) == gen, bar);
            __builtin_amdgcn_fence(__ATOMIC_ACQUIRE, "agent");
            asm volatile("s_waitcnt vmcnt(0)" ::: "memory");
        }
    }
    __syncthreads();
}

constexpr int NWAVES = 8, NTHR = NWAVES * 64;
constexpr int BATCH = 16, SEQ = 2048, DM = 1024, M = BATCH * SEQ;
constexpr int INW = 1280, AW = 512, KVW = 128, SW = 512, DFF = 2816, PLED = 256;
constexpr int NG = 32, NST = 64, TCH = 16, NCHB = SEQ / TCH;
constexpr float EPS = 1e-6f;
constexpr float LOG2E = 1.4426950408889634f;
constexpr float QSCALE = 0.125f * LOG2E;

constexpr size_t MiB = 1u << 20;
constexpr size_t WS_CTL = 0, CTL_ZERO_BYTES = 64 * 1024;
constexpr size_t WS_WIN = 1 * MiB, WS_GLU = 4 * MiB, WS_WOUT = 5 * MiB, WS_WUP = 7 * MiB, WS_WDN = 18 * MiB, WS_WPG = 24 * MiB, WS_WPP = 26 * MiB;
constexpr size_t WS_SSMG = 27 * MiB, WS_SSME = 31 * MiB, WS_SSMF = 33 * MiB, WS_AT = 35 * MiB;
constexpr size_t WS_ROPE = 36 * MiB, WS_SSQS = 38 * MiB, WS_SSQ1 = 39 * MiB, WS_SSQ2 = 41 * MiB;
constexpr size_t WS_A = 44 * MiB;
constexpr size_t WS_B = 108 * MiB;
constexpr size_t WS_C = 172 * MiB;
constexpr size_t WS_Q = WS_C, WS_K = WS_C + 32 * MiB, WS_V = WS_C + 40 * MiB, WS_U = WS_C + 48 * MiB;
constexpr size_t WS_D = 252 * MiB;
constexpr size_t WS_E = 284 * MiB;
constexpr size_t WS_END = 460 * MiB;
constexpr int CW_BAR = 4096;

constexpr int RING_BYTES = 131072;
constexpr int MISC_OFF = RING_BYTES + 4096;
constexpr int LDS_BYTES = 147456;

__device__ __forceinline__ float bf2f_lo(unsigned w) { return __uint_as_float(w << 16); }
__device__ __forceinline__ float bf2f_hi(unsigned w) { return __uint_as_float(w & 0xffff0000u); }
typedef float f32x2_t __attribute__((ext_vector_type(2))); typedef __bf16 bf16x2_t __attribute__((ext_vector_type(2)));
__device__ __forceinline__ unsigned pk2(float lo, float hi) { f32x2_t v = {lo, hi}; bf16x2_t b = __builtin_convertvector(v, bf16x2_t); return __builtin_bit_cast(unsigned, b); }
typedef unsigned u32x2 __attribute__((ext_vector_type(2)));
__device__ __forceinline__ float fast_exp2(float x) { return __builtin_amdgcn_exp2f(x); }
__device__ __forceinline__ float fast_rcp(float x) { return __builtin_amdgcn_rcpf(x); }
__device__ __forceinline__ float sigmoidf_fast(float v) { return fast_rcp(1.0f + fast_exp2(-LOG2E * v)); }
__device__ __forceinline__ float wave_sum(float v) {
#pragma unroll
    for (int o = 1; o < 64; o <<= 1) v += __shfl_xor(v, o);
    return v;
}
#define MFMA16(a, b, c) __builtin_amdgcn_mfma_f32_16x16x32_bf16((a), (b), (c), 0, 0, 0)

namespace pg8 {
__device__ __forceinline__ u32x4 pack8(const f32x4& a, const f32x4& b) { u32x4 w; w.x = pk2(a[0], a[1]); w.y = pk2(a[2], a[3]); w.z = pk2(b[0], b[1]); w.w = pk2(b[2], b[3]); return w; }
__device__ __forceinline__ float sq4(const f32x4& a) { return (a[0] * a[0] + a[1] * a[1]) + (a[2] * a[2] + a[3] * a[3]); }

struct EpiZ {
    static constexpr bool PERM = true, AFTER_DRAIN = false; static constexpr int MID_T = -1;
    bf16_t *Q, *K, *V, *U;
    __device__ __forceinline__ void operator()(const f32x4 (&acc)[2][2][4][2], const Unit& u, int wr, int wc, int fr, int fq) const {
        const int row0 = u.pm * BM + wr * 64 + fr, c8 = wc * 32 + 8 * fq;
#pragma unroll
        for (int ai = 0; ai < 2; ++ai)
#pragma unroll
            for (int m = 0; m < 4; ++m) { const size_t row = (size_t)(row0 + ai * HALF + m * 16);
#pragma unroll
                for (int bj = 0; bj < 2; ++bj) { const u32x4 w = pack8(acc[ai][bj][m][0], acc[ai][bj][m][1]); bf16_t* dst;
                    if (u.pn < 2) dst = Q + row * 512 + u.pn * 256 + bj * HALF + c8;
                    else if (u.pn == 2) dst = (bj == 0 ? K : V) + row * 128 + c8;
                    else { const int ui = (u.pn - 3) * 256 + bj * HALF + c8; dst = U + ((size_t)(ui >> 4) * ::M + row) * 16 + (ui & 15); }
                    *(u32x4*)dst = w; } }
    }
};
struct EpiB16 {
    static constexpr bool PERM = true, AFTER_DRAIN = false; static constexpr int MID_T = -1;
    bf16_t* O; int ldc;
    __device__ __forceinline__ void operator()(const f32x4 (&acc)[2][2][4][2], const Unit& u, int wr, int wc, int fr, int fq) const {
        const int row0 = u.pm * BM + wr * 64 + fr, col0 = u.pn * BM + wc * 32 + 8 * fq;
#pragma unroll
        for (int ai = 0; ai < 2; ++ai)
#pragma unroll
            for (int m = 0; m < 4; ++m) { bf16_t* rowp = O + (size_t)(row0 + ai * HALF + m * 16) * ldc + col0;
#pragma unroll
                for (int bj = 0; bj < 2; ++bj) *(u32x4*)(rowp + bj * HALF) = pack8(acc[ai][bj][m][0], acc[ai][bj][m][1]); }
    }
};
struct EpiGlu {
    static constexpr bool PERM = true, AFTER_DRAIN = false; static constexpr int MID_T = -1;
    const bf16_t* YG; const float* bias; bf16_t* MIX; float* SSQS;
    __device__ __forceinline__ void operator()(const f32x4 (&acc)[2][2][4][2], const Unit& u, int wr, int wc, int fr, int fq) const {
        const int row0 = u.pm * BM + wr * 64 + fr, col0 = u.pn * BM + wc * 32 + 8 * fq;
        f32x4 bv[2][2];
#pragma unroll
        for (int bj = 0; bj < 2; ++bj)
#pragma unroll
            for (int n = 0; n < 2; ++n) bv[bj][n] = *(const f32x4*)(bias + col0 + bj * HALF + 4 * n);
#pragma unroll
        for (int ai = 0; ai < 2; ++ai)
#pragma unroll
            for (int m = 0; m < 4; ++m) { const size_t row = (size_t)(row0 + ai * HALF + m * 16); float ss = 0.f;
#pragma unroll
                for (int bj = 0; bj < 2; ++bj) {
                    const u32x4 yw = *(const u32x4*)(YG + row * 512 + col0 + bj * HALF);
                    const f32x4 y0 = {bf2f_lo(yw.x), bf2f_hi(yw.x), bf2f_lo(yw.y), bf2f_hi(yw.y)}, y1 = {bf2f_lo(yw.z), bf2f_hi(yw.z), bf2f_lo(yw.w), bf2f_hi(yw.w)};
                    const f32x4 v0 = acc[ai][bj][m][0] + bv[bj][0], v1 = acc[ai][bj][m][1] + bv[bj][1];
                    f32x4 s0, s1;
#pragma unroll
                    for (int i = 0; i < 4; ++i) { s0[i] = y0[i] * sigmoidf_fast(v0[i]); s1[i] = y1[i] * sigmoidf_fast(v1[i]); }
                    ss += sq4(s0) + sq4(s1);
                    *(u32x4*)(MIX + row * 1024 + col0 + bj * HALF) = pack8(s0, s1); }
                ss += __shfl_xor(ss, 16); ss += __shfl_xor(ss, 32);
                if (fq == 0) SSQS[row * 8 + u.pn * 4 + wc] = ss; }
    }
};
struct EpiH1 {
    static constexpr bool PERM = true, AFTER_DRAIN = false; static constexpr int MID_T = 8;
    const float* X; float* OUT; bf16_t* HB; const float* SSQS; float* SSQ;
    __device__ __forceinline__ void mid(f32x4 (&acc)[2][2][4][2], const Unit& u, int wr, int fr) const {
        const int row0 = u.pm * BM + wr * 64 + fr;
#pragma unroll
        for (int ai = 0; ai < 2; ++ai)
#pragma unroll
            for (int m = 0; m < 4; ++m) { const size_t row = (size_t)(row0 + ai * HALF + m * 16);
                const f32x4 p0 = *(const f32x4*)(SSQS + row * 8), p1 = *(const f32x4*)(SSQS + row * 8 + 4);
                const float tot = ((p0[0] + p0[1]) + (p0[2] + p0[3])) + ((p1[0] + p1[1]) + (p1[2] + p1[3]));
                const float rs = rsqrtf(tot * (1.0f / 512.0f) + EPS);
#pragma unroll
                for (int bj = 0; bj < 2; ++bj)
#pragma unroll
                    for (int n = 0; n < 2; ++n) acc[ai][bj][m][n] *= rs;
                asm volatile("" ::: "memory"); }
    }
    __device__ __forceinline__ void operator()(const f32x4 (&acc)[2][2][4][2], const Unit& u, int wr, int wc, int fr, int fq) const {
        const int row0 = u.pm * BM + wr * 64 + fr, col0 = u.pn * BM + wc * 32 + 8 * fq;
#pragma unroll
        for (int ai = 0; ai < 2; ++ai)
#pragma unroll
            for (int m = 0; m < 4; ++m) { const size_t row = (size_t)(row0 + ai * HALF + m * 16); float ss = 0.f;
#pragma unroll
                for (int bj = 0; bj < 2; ++bj) { const size_t off = row * 1024 + col0 + bj * HALF;
                    const f32x4 h0 = *(const f32x4*)(X + off) + acc[ai][bj][m][0], h1 = *(const f32x4*)(X + off + 4) + acc[ai][bj][m][1];
                    ss += sq4(h0) + sq4(h1);
                    *(f32x4*)(OUT + off) = h0; *(f32x4*)(OUT + off + 4) = h1; *(u32x4*)(HB + off) = pack8(h0, h1); }
                ss += __shfl_xor(ss, 16); ss += __shfl_xor(ss, 32);
                if (fq == 0) SSQ[row * 16 + u.pn * 4 + wc] = ss; }
    }
};
__device__ __forceinline__ float row_rs16(const float* SSQ, size_t row) {
    const f32x4 p0 = *(const f32x4*)(SSQ + row * 16), p1 = *(const f32x4*)(SSQ + row * 16 + 4), p2 = *(const f32x4*)(SSQ + row * 16 + 8), p3 = *(const f32x4*)(SSQ + row * 16 + 12);
    const f32x4 s = (p0 + p1) + (p2 + p3);
    return rsqrtf(((s[0] + s[1]) + (s[2] + s[3])) * (1.0f / 1024.0f) + EPS);
}
struct EpiSwiGlu {
    static constexpr bool PERM = true, AFTER_DRAIN = false; static constexpr int MID_T = -1;
    const float* SSQ; bf16_t* ACT;
    __device__ __forceinline__ void operator()(const f32x4 (&acc)[2][2][4][2], const Unit& u, int wr, int wc, int fr, int fq) const {
        const int row0 = u.pm * BM + wr * 64 + fr, col0 = u.pn * HALF + wc * 32 + 8 * fq;
#pragma unroll
        for (int ai = 0; ai < 2; ++ai)
#pragma unroll
            for (int m = 0; m < 4; ++m) { const size_t row = (size_t)(row0 + ai * HALF + m * 16); const float rs = row_rs16(SSQ, row);
                f32x4 o[2];
#pragma unroll
                for (int n = 0; n < 2; ++n)
#pragma unroll
                    for (int i = 0; i < 4; ++i) { const float g = acc[ai][0][m][n][i] * rs, up = acc[ai][1][m][n][i] * rs; o[n][i] = g * up * sigmoidf_fast(g); }
                *(u32x4*)(ACT + row * DFF + col0) = pack8(o[0], o[1]); }
    }
};
struct EpiH2 {
    static constexpr bool PERM = true, AFTER_DRAIN = false; static constexpr int MID_T = -1;
    float* OUT; bf16_t* HB; float* SSQ;
    __device__ __forceinline__ void operator()(const f32x4 (&acc)[2][2][4][2], const Unit& u, int wr, int wc, int fr, int fq) const {
        const int row0 = u.pm * BM + wr * 64 + fr, col0 = u.pn * BM + wc * 32 + 8 * fq;
#pragma unroll
        for (int ai = 0; ai < 2; ++ai)
#pragma unroll
            for (int m = 0; m < 4; ++m) { const size_t row = (size_t)(row0 + ai * HALF + m * 16); float ss = 0.f;
#pragma unroll
                for (int bj = 0; bj < 2; ++bj) { const size_t off = row * 1024 + col0 + bj * HALF;
                    const f32x4 h0 = *(const f32x4*)(OUT + off) + acc[ai][bj][m][0], h1 = *(const f32x4*)(OUT + off + 4) + acc[ai][bj][m][1];
                    ss += sq4(h0) + sq4(h1);
                    *(f32x4*)(OUT + off) = h0; *(f32x4*)(OUT + off + 4) = h1; *(u32x4*)(HB + off) = pack8(h0, h1); }
                ss += __shfl_xor(ss, 16); ss += __shfl_xor(ss, 32);
                if (fq == 0) SSQ[row * 16 + u.pn * 4 + wc] = ss; }
    }
};
struct EpiPle {
    static constexpr bool PERM = true, AFTER_DRAIN = false; static constexpr int MID_T = -1;
    float* OUT; const float* SSQ; const float* bias; const bf16_t* PP;
    __device__ __forceinline__ void operator()(const f32x4 (&acc)[2][2][4][2], const Unit& u, int wr, int wc, int fr, int fq) const {
        const int row0 = u.pm * BM + wr * 64 + fr, col0 = u.pn * BM + wc * 32 + 8 * fq;
        f32x4 bv[2][2];
#pragma unroll
        for (int bj = 0; bj < 2; ++bj)
#pragma unroll
            for (int n = 0; n < 2; ++n) bv[bj][n] = *(const f32x4*)(bias + col0 + bj * HALF + 4 * n);
#pragma unroll
        for (int ai = 0; ai < 2; ++ai)
#pragma unroll
            for (int m = 0; m < 4; ++m) { const size_t row = (size_t)(row0 + ai * HALF + m * 16); const float rs = row_rs16(SSQ, row);
#pragma unroll
                for (int bj = 0; bj < 2; ++bj) { const size_t off = row * 1024 + col0 + bj * HALF;
                    const u32x4 pw = *(const u32x4*)(PP + off);
                    const f32x4 p0 = {bf2f_lo(pw.x), bf2f_hi(pw.x), bf2f_lo(pw.y), bf2f_hi(pw.y)}, p1 = {bf2f_lo(pw.z), bf2f_hi(pw.z), bf2f_lo(pw.w), bf2f_hi(pw.w)};
                    f32x4 h0 = *(const f32x4*)(OUT + off), h1 = *(const f32x4*)(OUT + off + 4);
#pragma unroll
                    for (int i = 0; i < 4; ++i) { h0[i] += sigmoidf_fast(acc[ai][bj][m][0][i] * rs + bv[bj][0][i]) * p0[i]; h1[i] += sigmoidf_fast(acc[ai][bj][m][1][i] * rs + bv[bj][1][i]) * p1[i]; }
                    *(f32x4*)(OUT + off) = h0; *(f32x4*)(OUT + off + 4) = h1; } }
    }
};
}

struct Args { const void* in[29]; float* out; unsigned char* ws; int ph_lo, ph_hi; };
enum { I_X = 0, I_P, I_POS, I_N1G, I_WIN, I_QG, I_KG, I_SINK, I_LRE, I_LIM, I_BRE, I_BIM, I_CRE, I_CIM, I_SD, I_LDT, I_GLUW, I_GLUB, I_AOG, I_SOG, I_WOUT, I_N2G,
       I_WG, I_WU, I_WD, I_PNG, I_WPG, I_BPG, I_WPP };

__device__ __forceinline__ void sincos_d(double x, double& s, double& c) {
    const double k = rint(x * 0.6366197723675814);
    double r = fma(-k, 1.5707963267341256, x); r = fma(-k, 6.077100506506192e-11, r);
    const double r2 = r * r;
    const double sp = r * (1.0 + r2 * (-1.0 / 6.0 + r2 * (1.0 / 120.0 + r2 * (-1.0 / 5040.0 + r2 * (1.0 / 362880.0 + r2 * (-1.0 / 39916800.0 + r2 * (1.0 / 6227020800.0)))))));
    const double cp = 1.0 + r2 * (-0.5 + r2 * (1.0 / 24.0 + r2 * (-1.0 / 720.0 + r2 * (1.0 / 40320.0 + r2 * (-1.0 / 3628800.0 + r2 * (1.0 / 479001600.0 + r2 * (-1.0 / 87178291200.0)))))));
    const int q = (int)k & 3;
    s = (q == 0) ? sp : (q == 1) ? cp : (q == 2) ? -sp : -cp;
    c = (q == 0) ? cp : (q == 1) ? -sp : (q == 2) ? -cp : sp;
}

__device__ __forceinline__ void tr_item(const float* __restrict__ W, int N, bf16* WT, int ldk, int kdst_off, const float* __restrict__ gain, int rowmul, int rowadd, int item, int lane, LAS float* scr) {
    const int nblk = N / 32, kb = item / nblk, nb = item % nblk, k0 = 64 * kb, n0 = 32 * nb;
#pragma unroll 8
    for (int i = 0; i < 32; ++i) { const int kk = 2 * i + (lane >> 5); float w = W[(size_t)(k0 + kk) * N + n0 + (lane & 31)]; if (gain) w *= gain[k0 + kk]; scr[kk * 33 + (lane & 31)] = w; }
    LDS_WAIT(); asm volatile("" ::: "memory");
    const int c = lane & 7;
#pragma unroll
    for (int j = 0; j < 4; ++j) { const int n = (lane >> 3) + 8 * j; const LAS float* s = scr + (8 * c) * 33 + n;
        v4u o; o.x = pk2(s[0 * 33], s[1 * 33]); o.y = pk2(s[2 * 33], s[3 * 33]); o.z = pk2(s[4 * 33], s[5 * 33]); o.w = pk2(s[6 * 33], s[7 * 33]);
        const int nn = n0 + n, drow = (nn >> 7) * rowmul + (nn & 127) + rowadd;
        *(v4u*)(WT + (size_t)drow * ldk + kdst_off + k0 + 8 * c) = o; }
    LDS_WAIT(); asm volatile("" ::: "memory");
}

__device__ __forceinline__ void ssm_tables(LAS unsigned char* lds, int g, int part, const Args& a, bf16* GT, bf16* ET, bf16* FT, f32x2_t* AT) {
    const int tid = threadIdx.x;
    LAS f32x2_t* P = (LAS f32x2_t*)lds;
    LAS f32x2_t* Bb = P + 64 * 17;
    LAS f32x2_t* Cc = Bb + 64 * 16;
    LAS float* Kt = (LAS float*)(Cc + 16 * 64);
    const float* lre = (const float*)a.in[I_LRE] + g * 64; const float* lim = (const float*)a.in[I_LIM] + g * 64;
    const float* bre = (const float*)a.in[I_BRE] + g * 1024; const float* bim = (const float*)a.in[I_BIM] + g * 1024;
    const float* cre = (const float*)a.in[I_CRE] + g * 1024; const float* cim = (const float*)a.in[I_CIM] + g * 1024;
    const float* dsk = (const float*)a.in[I_SD] + g * 16;
    const double dt = exp((double)((const float*)a.in[I_LDT])[g]);
    for (int t = tid; t < 64 * 17; t += NTHR) { const int n = t / 17, d = t % 17;
        const double lr = fmin((double)lre[n], -1e-4), li = (double)lim[n];
        const double mag = exp(lr * dt * (double)d), ang = li * dt * (double)d; double sn, cs; sincos_d(ang, sn, cs);
        P[t] = (f32x2_t){(float)(mag * cs), (float)(mag * sn)}; }
    for (int t = tid; t < 1024; t += NTHR) { const int n = t / 16;
        const double lr = fmin((double)lre[n], -1e-4), li = (double)lim[n];
        const double mag = exp(lr * dt), ang = li * dt; double sn, cs; sincos_d(ang, sn, cs);
        const double nr = mag * cs - 1.0, ni = mag * sn, den = lr * lr + li * li;
        const double fr = (nr * lr + ni * li) / den, fi = (ni * lr - nr * li) / den, br = (double)bre[t], bi = (double)bim[t];
        Bb[t] = (f32x2_t){(float)(fr * br - fi * bi), (float)(fr * bi + fi * br)};
        Cc[t] = (f32x2_t){cre[t], cim[t]}; }
    __syncthreads();
    for (int o = tid; o < 4096; o += NTHR) { const int d = o >> 8, c = (o >> 4) & 15, cp = o & 15; float s = 0.f;
        for (int n = 0; n < 64; ++n) { const f32x2_t cc = Cc[c * 64 + n], pp = P[n * 17 + d], bb = Bb[n * 16 + cp];
            const float tr = cc.x * pp.x - cc.y * pp.y, ti = cc.x * pp.y + cc.y * pp.x; s += tr * bb.x - ti * bb.y; }
        if (d == 0 && c == cp) s += dsk[c];
        Kt[o] = s; }
    __syncthreads();
    bf16* Gg = GT + (size_t)g * 65536; bf16* Eg = ET + (size_t)g * 32768; bf16* Fg = FT + (size_t)g * 32768;
    for (int q = tid; q < 1024; q += NTHR) { const int row = q >> 5, tau = 2 * part + (row >> 4), c = row & 15, col0 = (q & 31) * 8, j = col0 >> 4, c0 = col0 & 15;
        float v[8];
#pragma unroll
        for (int i = 0; i < 8; ++i) v[i] = (j <= tau) ? Kt[((tau - j) & 15) * 256 + c * 16 + c0 + i] : 0.f;
        v4u o; o.x = pk2(v[0], v[1]); o.y = pk2(v[2], v[3]); o.z = pk2(v[4], v[5]); o.w = pk2(v[6], v[7]);
        *(v4u*)(Gg + (size_t)(tau * 16 + c) * 256 + col0) = o; }
    { const int row = tid >> 5, np = 16 * part + row, n = np >> 1, ri = np & 1, col0 = (tid & 31) * 8, j = col0 >> 4, c0 = col0 & 15;
        const f32x2_t pp = P[n * 17 + (15 - j)]; float v[8];
#pragma unroll
        for (int i = 0; i < 8; ++i) { const f32x2_t bb = Bb[n * 16 + c0 + i]; v[i] = ri ? (pp.x * bb.y + pp.y * bb.x) : (pp.x * bb.x - pp.y * bb.y); }
        v4u o; o.x = pk2(v[0], v[1]); o.y = pk2(v[2], v[3]); o.z = pk2(v[4], v[5]); o.w = pk2(v[6], v[7]);
        *(v4u*)(Eg + (size_t)np * 256 + col0) = o; }
    { const int row = tid >> 4, tau = 2 * part + (row >> 4), c = row & 15, col0 = (tid & 15) * 8; float v[8];
#pragma unroll
        for (int i = 0; i < 8; ++i) { const int n = (col0 + i) >> 1, ri = (col0 + i) & 1; const f32x2_t cc = Cc[c * 64 + n], pp = P[n * 17 + tau + 1];
            v[i] = ri ? -(cc.x * pp.y + cc.y * pp.x) : (cc.x * pp.x - cc.y * pp.y); }
        v4u o; o.x = pk2(v[0], v[1]); o.y = pk2(v[2], v[3]); o.z = pk2(v[4], v[5]); o.w = pk2(v[6], v[7]);
        *(v4u*)(Fg + (size_t)(tau * 16 + c) * 128 + col0) = o; }
    if (part == 0 && tid < 64) AT[g * 64 + tid] = P[tid * 17 + 16];
    __syncthreads();
}

__device__ __forceinline__ void p0_prologue(LAS unsigned char* lds, const Args& a, int vcu, int G) {
    const int tid = threadIdx.x, lane = tid & 63, wave = __builtin_amdgcn_readfirstlane(tid >> 6);
    unsigned char* ws = a.ws;
    for (int u = vcu; u < NG * 8; u += G) ssm_tables(lds, u >> 3, u & 7, a, (bf16*)(ws + WS_SSMG), (bf16*)(ws + WS_SSME), (bf16*)(ws + WS_SSMF), (f32x2_t*)(ws + WS_AT));
    LAS float* scr = (LAS float*)(lds + wave * 16384);
    const int gw = vcu * NWAVES + wave, NGW = G * NWAVES;
    constexpr int I_IN = 16 * 40, I_GL = 8 * 16, I_OA = 8 * 32, I_OS = 8 * 32, I_G = 16 * 88, I_U = 16 * 88, I_D = 44 * 32, I_PG_ = 16 * 32, I_PP_ = 4 * 32;
    constexpr int NITEMS = I_IN + I_GL + I_OA + I_OS + I_G + I_U + I_D + I_PG_ + I_PP_;
    for (int it = gw; it < NITEMS; it += NGW) {
        int r = it;
        if (r < I_IN) { tr_item((const float*)a.in[I_WIN], INW, (bf16*)(ws + WS_WIN), 1024, 0, (const float*)a.in[I_N1G], 128, 0, r, lane, scr); continue; } r -= I_IN;
        if (r < I_GL) { tr_item((const float*)a.in[I_GLUW], 512, (bf16*)(ws + WS_GLU), 512, 0, nullptr, 128, 0, r, lane, scr); continue; } r -= I_GL;
        if (r < I_OA) { tr_item((const float*)a.in[I_WOUT], 1024, (bf16*)(ws + WS_WOUT), 1024, 512, (const float*)a.in[I_AOG], 128, 0, r, lane, scr); continue; } r -= I_OA;
        if (r < I_OS) { tr_item((const float*)a.in[I_WOUT] + 512 * 1024, 1024, (bf16*)(ws + WS_WOUT), 1024, 0, (const float*)a.in[I_SOG], 128, 0, r, lane, scr); continue; } r -= I_OS;
        if (r < I_G) { tr_item((const float*)a.in[I_WG], DFF, (bf16*)(ws + WS_WUP), 1024, 0, (const float*)a.in[I_N2G], 256, 0, r, lane, scr); continue; } r -= I_G;
        if (r < I_U) { tr_item((const float*)a.in[I_WU], DFF, (bf16*)(ws + WS_WUP), 1024, 0, (const float*)a.in[I_N2G], 256, 128, r, lane, scr); continue; } r -= I_U;
        if (r < I_D) { tr_item((const float*)a.in[I_WD], 1024, (bf16*)(ws + WS_WDN), DFF, 0, nullptr, 128, 0, r, lane, scr); continue; } r -= I_D;
        if (r < I_PG_) { tr_item((const float*)a.in[I_WPG], 1024, (bf16*)(ws + WS_WPG), 1024, 0, (const float*)a.in[I_PNG], 128, 0, r, lane, scr); continue; } r -= I_PG_;
        tr_item((const float*)a.in[I_WPP], 1024, (bf16*)(ws + WS_WPP), 256, 0, nullptr, 128, 0, r, lane, scr);
    }
    { const float* x = (const float*)a.in[I_X]; bf16* XN = (bf16*)(ws + WS_A);
      for (int m = gw; m < M; m += NGW) {
          const f32x4* xr = (const f32x4*)(x + (size_t)m * DM) + lane; f32x4 v[4]; float s = 0.f;
#pragma unroll
          for (int j = 0; j < 4; ++j) { v[j] = xr[64 * j]; s += (v[j].x * v[j].x + v[j].y * v[j].y) + (v[j].z * v[j].z + v[j].w * v[j].w); }
          const float rs = rsqrtf(wave_sum(s) * (1.f / DM) + EPS);
          unsigned long long* o8 = (unsigned long long*)(XN + (size_t)m * DM) + lane;
#pragma unroll
          for (int j = 0; j < 4; ++j) o8[64 * j] = (unsigned long long)pk2(v[j].x * rs, v[j].y * rs) | ((unsigned long long)pk2(v[j].z * rs, v[j].w * rs) << 32);
      } }
    { const int gt = vcu * NTHR + tid, NGT = G * NTHR;
      const f32x4* p4 = (const f32x4*)a.in[I_P]; v4u* pb = (v4u*)(ws + WS_D);
      for (int i = gt; i < M * PLED / 8; i += NGT) { const f32x4 v0 = p4[2 * i], v1 = p4[2 * i + 1]; v4u o; o.x = pk2(v0.x, v0.y); o.y = pk2(v0.z, v0.w); o.z = pk2(v1.x, v1.y); o.w = pk2(v1.z, v1.w); pb[i] = o; }
      const int* pos = (const int*)a.in[I_POS]; float* rope = (float*)(ws + WS_ROPE);
      for (int i = gt; i < M * 8; i += NGT) { const int tok = i >> 3, k = i & 7;
          const double inv = (k == 0) ? 1.0 : (k == 1) ? 0.19392274474868576 : (k == 2) ? 0.03760603093086393 : (k == 3) ? 0.007292664737217109 : (k == 4) ? 0.001414213562373095
                           : (k == 5) ? 0.0002742481756762073 : (k == 6) ? 5.318295896944988e-05 : 1.031338537721246e-05;
          double sn, cs; sincos_d((double)pos[tok] * inv, sn, cs); rope[tok * 16 + k] = (float)cs; rope[tok * 16 + 8 + k] = (float)sn; } }
}

constexpr int ATT_KSTR = 144, ATT_VSTR = 400;
constexpr int ATT_KN = 0, ATT_VT = 2 * 192 * ATT_KSTR, ATT_SSQ = ATT_VT + 2 * 64 * ATT_VSTR, ATT_END = ATT_SSQ + 8 * 64 * 4;
static_assert(ATT_END <= RING_BYTES, "attention LDS");
__device__ __forceinline__ void attn_unit(LAS unsigned char* lds, int b, int c, const bf16* __restrict__ Q, const bf16* __restrict__ Kb, const bf16* __restrict__ Vb, const float* __restrict__ rope,
                                          const float* __restrict__ gq, const float* __restrict__ gk, const float* __restrict__ sinks, bf16* MIX) {
    const int tid = threadIdx.x, lane = tid & 63, wid = __builtin_amdgcn_readfirstlane(tid >> 6);
    for (int it = 0; it < 6; ++it) {
        const int p = it * 64 + (tid >> 3), sub = tid & 7, kvh = p / 192, jb = p % 192, tchunk = c - 2 + (jb >> 6);
        const long tok = (long)b * SEQ + tchunk * 64 + (jb & 63);
        v4u kraw = {0u, 0u, 0u, 0u}, vraw = {0u, 0u, 0u, 0u};
        if (tchunk >= 0) { kraw = *(const v4u*)(Kb + tok * 128 + kvh * 64 + sub * 8); vraw = *(const v4u*)(Vb + tok * 128 + kvh * 64 + sub * 8); }
        float v[8] = {bf2f_lo(kraw.x), bf2f_hi(kraw.x), bf2f_lo(kraw.y), bf2f_hi(kraw.y), bf2f_lo(kraw.z), bf2f_hi(kraw.z), bf2f_lo(kraw.w), bf2f_hi(kraw.w)};
        float ss = 0.f;
#pragma unroll
        for (int i = 0; i < 8; ++i) ss += v[i] * v[i];
        ss += __shfl_xor(ss, 1); ss += __shfl_xor(ss, 2); ss += __shfl_xor(ss, 4);
        const float rs = rsqrtf(ss * (1.f / 64.f) + EPS);
        float o[8];
#pragma unroll
        for (int i = 0; i < 8; ++i) { v[i] *= rs * gk[sub * 8 + i]; o[i] = __shfl_xor(v[i], 1); }
        if (sub < 2 && tchunk >= 0) { const float* cs = rope + tok * 16;
#pragma unroll
            for (int i = 0; i < 8; ++i) { const float cv = cs[i], sv = cs[8 + i]; v[i] = (sub == 0) ? (v[i] * cv - o[i] * sv) : (o[i] * sv + v[i] * cv); } }
        v4u kw; kw.x = pk2(v[0], v[1]); kw.y = pk2(v[2], v[3]); kw.z = pk2(v[4], v[5]); kw.w = pk2(v[6], v[7]);
        *(LAS v4u*)(lds + ATT_KN + (kvh * 192 + jb) * ATT_KSTR + sub * 16) = kw;
        LAS unsigned short* vt = (LAS unsigned short*)(lds + ATT_VT + (kvh * 64 + sub * 8) * ATT_VSTR + jb * 2);
        vt[0 * (ATT_VSTR / 2)] = (unsigned short)(vraw.x & 0xffffu); vt[1 * (ATT_VSTR / 2)] = (unsigned short)(vraw.x >> 16);
        vt[2 * (ATT_VSTR / 2)] = (unsigned short)(vraw.y & 0xffffu); vt[3 * (ATT_VSTR / 2)] = (unsigned short)(vraw.y >> 16);
        vt[4 * (ATT_VSTR / 2)] = (unsigned short)(vraw.z & 0xffffu); vt[5 * (ATT_VSTR / 2)] = (unsigned short)(vraw.z >> 16);
        vt[6 * (ATT_VSTR / 2)] = (unsigned short)(vraw.w & 0xffffu); vt[7 * (ATT_VSTR / 2)] = (unsigned short)(vraw.w >> 16);
    }
    __syncthreads();
    const int hq = wid, kvh = wid >> 2, fr = lane & 15, quad = lane >> 4;
    const float sink2 = sinks[hq] * LOG2E;
    const int kt0 = (c >= 2) ? 0 : (2 - c) * 4;
    LAS float* ssq = (LAS float*)(lds + ATT_SSQ);
    f32x4 O[4][4];
#pragma unroll
    for (int qt = 0; qt < 4; ++qt) {
        const long tokq = (long)b * SEQ + c * 64 + qt * 16 + fr;
        const v4u q0 = *(const v4u*)(Q + tokq * 512 + hq * 64 + quad * 8), q1 = *(const v4u*)(Q + tokq * 512 + hq * 64 + 32 + quad * 8);
        float v0[8] = {bf2f_lo(q0.x), bf2f_hi(q0.x), bf2f_lo(q0.y), bf2f_hi(q0.y), bf2f_lo(q0.z), bf2f_hi(q0.z), bf2f_lo(q0.w), bf2f_hi(q0.w)};
        float v1[8] = {bf2f_lo(q1.x), bf2f_hi(q1.x), bf2f_lo(q1.y), bf2f_hi(q1.y), bf2f_lo(q1.z), bf2f_hi(q1.z), bf2f_lo(q1.w), bf2f_hi(q1.w)};
        float ss = 0.f;
#pragma unroll
        for (int i = 0; i < 8; ++i) ss += v0[i] * v0[i] + v1[i] * v1[i];
        ss += __shfl_xor(ss, 16); ss += __shfl_xor(ss, 32);
        const float rs = rsqrtf(ss * (1.f / 64.f) + EPS) * QSCALE;
        float o[8];
#pragma unroll
        for (int i = 0; i < 8; ++i) { v0[i] *= rs * gq[quad * 8 + i]; v1[i] *= rs * gq[32 + quad * 8 + i]; o[i] = __shfl_xor(v0[i], 16); }
        if (quad < 2) { const float* cs = rope + tokq * 16;
#pragma unroll
            for (int i = 0; i < 8; ++i) { const float cv = cs[i], sv = cs[8 + i]; v0[i] = (quad == 0) ? (v0[i] * cv - o[i] * sv) : (o[i] * sv + v0[i] * cv); } }
        v4u w0, w1; w0.x = pk2(v0[0], v0[1]); w0.y = pk2(v0[2], v0[3]); w0.z = pk2(v0[4], v0[5]); w0.w = pk2(v0[6], v0[7]);
        w1.x = pk2(v1[0], v1[1]); w1.y = pk2(v1[2], v1[3]); w1.z = pk2(v1[4], v1[5]); w1.w = pk2(v1[6], v1[7]);
        const bf16x8 qf0 = __builtin_bit_cast(bf16x8, w0), qf1 = __builtin_bit_cast(bf16x8, w1);
        f32x4 S[12];
#pragma unroll
        for (int kt = 0; kt < 12; ++kt) {
            const LAS unsigned char* kp = lds + ATT_KN + (kvh * 192 + kt * 16 + fr) * ATT_KSTR + quad * 16;
            const bf16x8 a0 = *(const LAS bf16x8*)kp, a1 = *(const LAS bf16x8*)(kp + 64);
            f32x4 s = {0.f, 0.f, 0.f, 0.f}; s = MFMA16(a0, qf0, s); s = MFMA16(a1, qf1, s); S[kt] = s; }
        float mx = -1e30f;
#pragma unroll
        for (int kt = 0; kt < 12; ++kt) if (kt >= kt0) mx = fmaxf(mx, fmaxf(fmaxf(S[kt][0], S[kt][1]), fmaxf(S[kt][2], S[kt][3])));
        mx = fmaxf(mx, __shfl_xor(mx, 16)); mx = fmaxf(mx, __shfl_xor(mx, 32)); mx = fmaxf(mx, sink2);
        float sum = 0.f;
#pragma unroll
        for (int kt = 0; kt < 12; ++kt)
#pragma unroll
            for (int r = 0; r < 4; ++r) { const float pz = (kt >= kt0) ? fast_exp2(S[kt][r] - mx) : 0.f; S[kt][r] = pz; sum += pz; }
        sum += __shfl_xor(sum, 16); sum += __shfl_xor(sum, 32);
        const float inv = 1.0f / (sum + fast_exp2(sink2 - mx));
#pragma unroll
        for (int dt = 0; dt < 4; ++dt) O[qt][dt] = (f32x4){0.f, 0.f, 0.f, 0.f};
#pragma unroll
        for (int s6 = 0; s6 < 6; ++s6) {
            v4u pw; pw.x = pk2(S[2 * s6][0] * inv, S[2 * s6][1] * inv); pw.y = pk2(S[2 * s6][2] * inv, S[2 * s6][3] * inv);
            pw.z = pk2(S[2 * s6 + 1][0] * inv, S[2 * s6 + 1][1] * inv); pw.w = pk2(S[2 * s6 + 1][2] * inv, S[2 * s6 + 1][3] * inv);
            const bf16x8 pa = __builtin_bit_cast(bf16x8, pw);
#pragma unroll
            for (int dt = 0; dt < 4; ++dt) {
                const LAS unsigned char* vp = lds + ATT_VT + (kvh * 64 + dt * 16 + fr) * ATT_VSTR + (s6 * 32 + quad * 4) * 2;
                const u32x2 lo = *(const LAS u32x2*)vp, hi = *(const LAS u32x2*)(vp + 32);
                v4u bw; bw.x = lo.x; bw.y = lo.y; bw.z = hi.x; bw.w = hi.y;
                O[qt][dt] = MFMA16(pa, __builtin_bit_cast(bf16x8, bw), O[qt][dt]); } }
#pragma unroll
        for (int r = 0; r < 4; ++r) { float s2 = 0.f;
#pragma unroll
            for (int dt = 0; dt < 4; ++dt) s2 += O[qt][dt][r] * O[qt][dt][r];
            s2 += __shfl_xor(s2, 1); s2 += __shfl_xor(s2, 2); s2 += __shfl_xor(s2, 4); s2 += __shfl_xor(s2, 8);
            if (fr == 0) ssq[hq * 64 + qt * 16 + quad * 4 + r] = s2; }
    }
    __syncthreads();
#pragma unroll
    for (int qt = 0; qt < 4; ++qt)
#pragma unroll
        for (int r = 0; r < 4; ++r) { const int q = qt * 16 + quad * 4 + r; float tot = 0.f;
#pragma unroll
            for (int h = 0; h < 8; ++h) tot += ssq[h * 64 + q];
            const float rs = rsqrtf(tot * (1.f / 512.f) + EPS);
            bf16* dst = MIX + ((size_t)b * SEQ + c * 64 + q) * 1024 + 512 + hq * 64 + fr;
#pragma unroll
            for (int dt = 0; dt < 4; ++dt) dst[dt * 16] = (bf16)(pk2(O[qt][dt][r] * rs, 0.f) & 0xffffu); }
    __syncthreads();
}

constexpr int SSM_ROWB = 528;
static_assert(256 * SSM_ROWB <= MISC_OFF, "SSM LDS");
__device__ __forceinline__ float gelu_tanh(float y) { const float z = 0.7978845608028654f * (y + 0.044715f * y * y * y); return y * fast_rcp(1.0f + fast_exp2(-2.0f * LOG2E * z)); }
__device__ __forceinline__ void ssm_unit(LAS unsigned char* lds, int g, int bp, const bf16* __restrict__ U, const bf16* __restrict__ ET, const bf16* __restrict__ GT, const bf16* __restrict__ FT,
                                         const f32x2_t* __restrict__ AT, bf16* YG) {
    const int tid = threadIdx.x, lane = tid & 63, wid = __builtin_amdgcn_readfirstlane(tid >> 6), fr = lane & 15, fq = lane >> 4;
    const bf16* Ug = U + (size_t)g * M * 16;
    const bf16* ua0 = Ug + (size_t)(2 * bp) * SEQ * 16 + (size_t)(16 * wid + fr) * 256 + fq * 8;
    const bf16* ua1 = ua0 + (size_t)SEQ * 16;
    { bf16x8 a[2][8];
#pragma unroll
      for (int ks = 0; ks < 8; ++ks) { a[0][ks] = *(const bf16x8*)(ua0 + ks * 32); a[1][ks] = *(const bf16x8*)(ua1 + ks * 32); }
      const bf16* E = ET + (size_t)g * 32768 + (size_t)fr * 256 + fq * 8;
#pragma unroll 1
      for (int nt = 0; nt < 8; ++nt) { f32x4 c0 = {0.f, 0.f, 0.f, 0.f}, c1 = {0.f, 0.f, 0.f, 0.f};
#pragma unroll
          for (int ks = 0; ks < 8; ++ks) { const bf16x8 bb = *(const bf16x8*)(E + (size_t)nt * 16 * 256 + ks * 32); c0 = MFMA16(a[0][ks], bb, c0); c1 = MFMA16(a[1][ks], bb, c1); }
#pragma unroll
          for (int r = 0; r < 4; ++r) { *(LAS float*)(lds + (16 * wid + 4 * fq + r) * SSM_ROWB + (nt * 16 + fr) * 4) = c0[r];
                                        *(LAS float*)(lds + (128 + 16 * wid + 4 * fq + r) * SSM_ROWB + (nt * 16 + fr) * 4) = c1[r]; } } }
    __syncthreads();
    if (wid < 2) { const f32x2_t aT = AT[g * 64 + lane]; float cr = 0.f, ci = 0.f;
#pragma unroll 1
        for (int k0 = 0; k0 < NCHB; k0 += 8) { u32x2 sv[8];
#pragma unroll
            for (int i = 0; i < 8; ++i) sv[i] = *(const LAS u32x2*)(lds + (wid * 128 + k0 + i) * SSM_ROWB + lane * 8);
            LDS_WAIT(); asm volatile("" ::: "memory");
#pragma unroll
            for (int i = 0; i < 8; ++i) { *(LAS unsigned*)(lds + (wid * 128 + k0 + i) * SSM_ROWB + lane * 4) = pk2(cr, ci);
                const float sr = __uint_as_float(sv[i].x), si = __uint_as_float(sv[i].y), nr = aT.x * cr - aT.y * ci + sr, ni = aT.x * ci + aT.y * cr + si; cr = nr; ci = ni; }
            asm volatile("" ::: "memory"); } }
    __syncthreads();
    const bf16* Gp = GT + (size_t)g * 65536 + (size_t)fr * 256 + fq * 8;
    const bf16* Fp = FT + (size_t)g * 32768 + (size_t)fr * 128 + fq * 8;
#pragma unroll 1
    for (int nh = 0; nh < 2; ++nh) {
        f32x4 acc[2][8];
#pragma unroll
        for (int mt = 0; mt < 2; ++mt)
#pragma unroll
            for (int n8 = 0; n8 < 8; ++n8) acc[mt][n8] = (f32x4){0.f, 0.f, 0.f, 0.f};
#pragma unroll 1
        for (int ks = 0; ks < 8; ++ks) {
            if (2 * ks > nh * 8 + 7) break;
            const bf16x8 a0 = *(const bf16x8*)(ua0 + ks * 32), a1 = *(const bf16x8*)(ua1 + ks * 32);
#pragma unroll
            for (int n8 = 0; n8 < 8; ++n8) { const int nt = nh * 8 + n8;
                if (nt >= 2 * ks) { const bf16x8 bb = *(const bf16x8*)(Gp + (size_t)nt * 16 * 256 + ks * 32); acc[0][n8] = MFMA16(a0, bb, acc[0][n8]); acc[1][n8] = MFMA16(a1, bb, acc[1][n8]); } } }
#pragma unroll 1
        for (int ks = 0; ks < 4; ++ks) {
            const bf16x8 ca0 = *(const LAS bf16x8*)(lds + (16 * wid + fr) * SSM_ROWB + (ks * 32 + fq * 8) * 2), ca1 = *(const LAS bf16x8*)(lds + (128 + 16 * wid + fr) * SSM_ROWB + (ks * 32 + fq * 8) * 2);
#pragma unroll
            for (int n8 = 0; n8 < 8; ++n8) { const int nt = nh * 8 + n8;
                const bf16x8 bb = *(const bf16x8*)(Fp + (size_t)nt * 16 * 128 + ks * 32); acc[0][n8] = MFMA16(ca0, bb, acc[0][n8]); acc[1][n8] = MFMA16(ca1, bb, acc[1][n8]); } }
#pragma unroll
        for (int mt = 0; mt < 2; ++mt)
#pragma unroll
            for (int n8 = 0; n8 < 8; ++n8)
#pragma unroll
                for (int r = 0; r < 4; ++r) { const size_t tok = (size_t)(2 * bp + mt) * SEQ + (size_t)(16 * wid + 4 * fq + r) * 16 + nh * 8 + n8;
                    YG[tok * 512 + g * 16 + fr] = (bf16)(pk2(gelu_tanh(acc[mt][n8][r]), 0.f) & 0xffffu); }
    }
    __syncthreads();
}

__global__ void __launch_bounds__(NTHR, 2) hymba_fwd(Args args) {
    extern __shared__ __attribute__((aligned(16))) unsigned char lds_raw[];
    LAS unsigned char* lds = (LAS unsigned char*)lds_raw;
    const int tid = threadIdx.x;
    const int G = gridDim.x, bx = blockIdx.x;
    const int vcu = (G % 8 == 0) ? (bx % 8) * (G / 8) + bx / 8 : bx;
    unsigned char* ws = args.ws;
    const int lo = args.ph_lo, hi = args.ph_hi;
#if MK_N_LAUNCHES == 1
#if MK_BARRIER == 1
    volatile LAS unsigned* MISC = (volatile LAS unsigned*)(lds + MISC_OFF);
    if (tid < 32) MISC[tid] = 0u;
    __syncthreads();
    XcdBarrier bar = xcd_barrier_post((unsigned*)(ws + WS_CTL) + CW_BAR, MISC + 8);
#define GRID_BAR() xcd_barrier(bar)
#else
    cg::grid_group grid = cg::this_grid();
#define GRID_BAR() grid.sync()
#endif
#else
#define GRID_BAR() do {} while (0)
#endif
#ifndef PHASE_MASK
#define PHASE_MASK 0xff
#endif
#define IN(k) ((((PHASE_MASK) >> (k)) & 1) && lo <= (k) && (k) < hi)
#define SEAM(k) do { if (IN(k) && IN((k) + 1)) GRID_BAR(); } while (0)

    if (IN(0)) { p0_prologue(lds, args, vcu, G); }
    SEAM(0);
    if (IN(1)) {
#ifndef NO_Z
        { pg8::Gemm g{(const pg8::bf16_t*)(ws + WS_A), (const pg8::bf16_t*)(ws + WS_WIN), M, INW, DM}; pg8::StaticOrder S; S.init(M, INW, G, bx);
          pg8::EpiZ E{(pg8::bf16_t*)(ws + WS_Q), (pg8::bf16_t*)(ws + WS_K), (pg8::bf16_t*)(ws + WS_V), (pg8::bf16_t*)(ws + WS_U)};
          pg8::gemm_phase<pg8::EpiZ, pg8::StaticOrder, true, true>(lds, g, S, E); }
#endif
#ifndef NO_PP
        { pg8::Gemm g{(const pg8::bf16_t*)(ws + WS_D), (const pg8::bf16_t*)(ws + WS_WPP), M, DM, PLED}; pg8::StaticOrder S;
          const int half = G / 2;
          if (G == 256) S.init(M, DM, half, bx >= half ? bx - half : 0); else S.init(M, DM, G, bx);
          pg8::EpiB16 E{(pg8::bf16_t*)(ws + WS_B), DM};
          if (G != 256 || bx >= half) pg8::gemm_phase<pg8::EpiB16, pg8::StaticOrder, true, true>(lds, g, S, E); }
#endif
    }
    SEAM(1);
    if (IN(2)) {
#ifndef NO_SSM
        for (int u = vcu; u < NG * 8; u += G)
            ssm_unit(lds, u >> 3, u & 7, (const bf16*)(ws + WS_U), (const bf16*)(ws + WS_SSME), (const bf16*)(ws + WS_SSMG), (const bf16*)(ws + WS_SSMF), (const f32x2_t*)(ws + WS_AT), (bf16*)(ws + WS_D));
#endif
#ifndef NO_ATT
        for (int u = vcu * 2; u < BATCH * 32; u += G * 2)
            for (int i = 0; i < 2; ++i) { const int uu = u + i;
                attn_unit(lds, uu >> 5, uu & 31, (const bf16*)(ws + WS_Q), (const bf16*)(ws + WS_K), (const bf16*)(ws + WS_V), (const float*)(ws + WS_ROPE),
                          (const float*)args.in[I_QG], (const float*)args.in[I_KG], (const float*)args.in[I_SINK], (bf16*)(ws + WS_A)); }
#endif
    }
    SEAM(2);
    if (IN(3)) {
        pg8::Gemm g{(const pg8::bf16_t*)(ws + WS_D), (const pg8::bf16_t*)(ws + WS_GLU), M, SW, SW}; pg8::StaticOrder S; S.init(M, SW, G, bx);
        pg8::EpiGlu E{(const pg8::bf16_t*)(ws + WS_D), (const float*)args.in[I_GLUB], (pg8::bf16_t*)(ws + WS_A), (float*)(ws + WS_SSQS)};
        pg8::gemm_phase<pg8::EpiGlu, pg8::StaticOrder, true, true>(lds, g, S, E);
    }
    SEAM(3);
    if (IN(4)) {
        pg8::Gemm g{(const pg8::bf16_t*)(ws + WS_A), (const pg8::bf16_t*)(ws + WS_WOUT), M, DM, DM}; pg8::StaticOrder S; S.init(M, DM, G, bx);
        pg8::EpiH1 E{(const float*)args.in[I_X], args.out, (pg8::bf16_t*)(ws + WS_C), (const float*)(ws + WS_SSQS), (float*)(ws + WS_SSQ1)};
        pg8::gemm_phase<pg8::EpiH1, pg8::StaticOrder, true, true>(lds, g, S, E);
    }
    SEAM(4);
    if (IN(5)) {
        pg8::Gemm g{(const pg8::bf16_t*)(ws + WS_C), (const pg8::bf16_t*)(ws + WS_WUP), M, 2 * DFF, DM}; pg8::StaticOrder S; S.init(M, 2 * DFF, G, bx);
        pg8::EpiSwiGlu E{(const float*)(ws + WS_SSQ1), (pg8::bf16_t*)(ws + WS_E)};
        pg8::gemm_phase<pg8::EpiSwiGlu, pg8::StaticOrder, true, true>(lds, g, S, E);
    }
    SEAM(5);
    if (IN(6)) {
        pg8::Gemm g{(const pg8::bf16_t*)(ws + WS_E), (const pg8::bf16_t*)(ws + WS_WDN), M, DM, DFF}; pg8::StaticOrder S; S.init(M, DM, G, bx);
        pg8::EpiH2 E{args.out, (pg8::bf16_t*)(ws + WS_A), (float*)(ws + WS_SSQ2)};
        pg8::gemm_phase<pg8::EpiH2, pg8::StaticOrder, true, true>(lds, g, S, E);
    }
    SEAM(6);
    if (IN(7)) {
        pg8::Gemm g{(const pg8::bf16_t*)(ws + WS_A), (const pg8::bf16_t*)(ws + WS_WPG), M, DM, DM}; pg8::StaticOrder S; S.init(M, DM, G, bx);
        pg8::EpiPle E{args.out, (const float*)(ws + WS_SSQ2), (const float*)args.in[I_BPG], (const pg8::bf16_t*)(ws + WS_B)};
        pg8::gemm_phase<pg8::EpiPle, pg8::StaticOrder, true, true>(lds, g, S, E);
    }
#undef IN
#undef SEAM
}

extern "C" void kernel_launch(void* const* d_in, const int* in_sizes, int n_in, void* d_out, int out_size, void* d_ws, size_t ws_size, hipStream_t stream) {
    static int grid = 0;
    if (grid == 0) {
        if (n_in != 29 || in_sizes[0] != M * DM || out_size != M * DM || ws_size < WS_END) { fprintf(stderr, "kernel_launch: unexpected shapes (n_in %d, in0 %d, out %d, ws %zu); nothing launched\n", n_in, n_in > 0 ? in_sizes[0] : -1, out_size, ws_size); grid = -1; return; }
        int dev = 0, cus = 0, per_cu = 0;
        if (hipGetDevice(&dev) != hipSuccess || hipDeviceGetAttribute(&cus, hipDeviceAttributeMultiprocessorCount, dev) != hipSuccess) { grid = -1; return; }
        if (hipFuncSetAttribute((const void*)hymba_fwd, hipFuncAttributeMaxDynamicSharedMemorySize, LDS_BYTES) != hipSuccess) { fprintf(stderr, "kernel_launch: hipFuncSetAttribute failed\n"); grid = -1; return; }
        if (hipOccupancyMaxActiveBlocksPerMultiprocessor(&per_cu, (const void*)hymba_fwd, NTHR, LDS_BYTES) != hipSuccess || per_cu < 1) { fprintf(stderr, "kernel_launch: occupancy query says %d blocks per CU\n", per_cu); per_cu = 1; }
        (void)hipGetLastError();
        grid = cus * (per_cu < 1 ? 1 : 1);
    }
    if (grid < 0) return;
    (void)hipMemsetAsync((char*)d_ws + WS_CTL, 0, CTL_ZERO_BYTES, stream);
    Args a{};
    for (int i = 0; i < 29; ++i) a.in[i] = d_in[i];
    a.out = (float*)d_out; a.ws = (unsigned char*)d_ws;
#if MK_N_LAUNCHES == 1
    a.ph_lo = 0; a.ph_hi = 8;
    void* kargs[] = {&a};
    hipError_t e = hipLaunchCooperativeKernel((const void*)hymba_fwd, dim3(grid), dim3(NTHR), kargs, LDS_BYTES, stream);
    if (e != hipSuccess) fprintf(stderr, "kernel_launch: cooperative launch failed: %s (grid %d)\n", hipGetErrorString(e), grid);
#else
    for (int ph = 0; ph < 8; ++ph) { a.ph_lo = ph; a.ph_hi = ph + 1; hipLaunchKernelGGL(hymba_fwd, dim3(grid), dim3(NTHR), LDS_BYTES, stream, a); }
#endif
}
```

```cpp
#include <hip/hip_runtime.h>
#include <hip/hip_cooperative_groups.h>
#include <cstdio>
#include <cstdint>
namespace cg = cooperative_groups;

#ifndef MK_N_LAUNCHES
#define MK_N_LAUNCHES 1
#endif
#ifndef MK_BARRIER
#define MK_BARRIER 1
#endif

namespace pg8 {
#define PG8_LAS __attribute__((address_space(3)))
typedef unsigned short bf16_t;
typedef short bf16x8 __attribute__((ext_vector_type(8)));
typedef float f32x4 __attribute__((ext_vector_type(4)));
typedef unsigned u32x4 __attribute__((ext_vector_type(4)));
constexpr int BM = 256, BK = 64, HALF = 128, HTB = HALF * BK * 2  , STAGE_BYTES = 8 * HTB, NXCD = 8, WGM = 8;

__host__ __device__ __forceinline__ int lds_byte(int r, int c) { const int st = (r >> 4) * 2 + (c >> 5), rr = r & 15, cc = c & 31, ob = rr * 64 + cc * 2; return st * 1024 + (ob ^ (((ob >> 9) & 1) << 5)); }
__host__ __device__ __forceinline__ void stage_rc(int b, int& R, int& C) { const int st = b / 1024, sb = b % 1024, swz = sb ^ (((sb >> 9) & 1) << 5); R = (st >> 1) * 16 + swz / 64; C = (st & 1) * 32 + (swz % 64) / 2; }
__host__ __device__ __forceinline__ int perm32(int rho) { const int n = rho >> 4, i = rho & 15; return 8 * (i >> 2) + 4 * n + (i & 3); }

struct Unit { int pm, pn; };
struct Gemm { const bf16_t* A; const bf16_t* Bt; int M, N, K; int lda; };

struct StaticOrder {
    int nM, nN, nwg, G, c;
    __host__ __device__ void init(int M, int N, int G_, int c_) { nM = M / BM; nN = N / BM; nwg = nM * nN; G = G_; c = c_; }
    __host__ __device__ bool next(int i, Unit& u) const {
        const long L = (long)i * G + c; if (L >= nwg) return false;
        int wgid = (int)L; { const int q = nwg / NXCD, r = nwg % NXCD, xcd = wgid % NXCD, off = wgid / NXCD; wgid = (xcd < r ? xcd * (q + 1) : r * (q + 1) + (xcd - r) * q) + off; }
        const int nig = WGM * nN, gid = wgid / nig, fm = gid * WGM, gsz = (nM - fm) < WGM ? (nM - fm) : WGM;
        u.pm = fm + ((wgid % nig) % gsz); u.pn = (wgid % nig) / gsz; return true;
    }
    __device__ __forceinline__ void a_ready(const Unit&) const {}
    __device__ __forceinline__ void done(const Unit&) const {}
};

__device__ __forceinline__ unsigned cvt_pk_bf16(float lo, float hi) { unsigned r; asm volatile("v_cvt_pk_bf16_f32 %0, %1, %2" : "=v"(r) : "v"(lo), "v"(hi)); return r; }
typedef float f32x2 __attribute__((ext_vector_type(2)));
template <class Epi, class Sched, bool ALIGN_EPI = false, bool SP2 = false>
__device__ __forceinline__ void gemm_phase(PG8_LAS unsigned char* lds, const Gemm g, const Sched& S, const Epi& E_) {
    Epi E = E_;
    const int tid = threadIdx.x, wid = __builtin_amdgcn_readfirstlane(tid >> 6), lane = tid & 63, wr = wid >> 2, wc = wid & 3, fr = lane & 15, fq = lane >> 4;
    int K_ = g.K; asm volatile("" : "+s"(K_));
    const int K = K_, nt = K / BK; int lda_ = g.lda ? g.lda : g.K; asm volatile("" : "+s"(lda_)); const int lda = lda_;
    unsigned voffA[2], voffB[2];
#pragma unroll
    for (int i = 0; i < 2; ++i) { int R, C; stage_rc(tid * 16 + i * 8192, R, C); const int Rb = Epi::PERM ? ((R & ~31) + perm32(R & 31)) : R;
        voffA[i] = (unsigned)(R * lda + C) * 2u; voffB[i] = (unsigned)(Rb * K + C) * 2u; }
    const size_t kstep = (size_t)(BK * 2);
    const size_t hstep = (size_t)HALF * K * 2;
    const size_t tstep = 2 * hstep; const size_t hstepA = (size_t)HALF * lda * 2, tstepA = 2 * hstepA;
    const unsigned ldsw = (unsigned)wid * 1024u;
    const int aoff = lds_byte(wr * 64 + fr, fq * 8), boff = lds_byte(wc * 32 + fr, fq * 8);
#define PG8_SA(b, h) (((b) * 2 + (h)) * HTB)
#define PG8_SB(b, h) ((4 + (b) * 2 + (h)) * HTB)
#define PG8_STAGE(bufoff, gbase, voff) do { _Pragma("unroll") for (int _i = 0; _i < 2; ++_i) \
        __builtin_amdgcn_global_load_lds((const unsigned*)((const char*)(gbase) + (voff)[_i]), (PG8_LAS unsigned*)(lds + (bufoff) + ldsw + _i * 8192), 16, 0, 0); } while (0)
#define PG8_LDA(dst, b, h) do { _Pragma("unroll") for (int m = 0; m < 4; ++m) _Pragma("unroll") for (int k = 0; k < 2; ++k) dst[m][k] = *(const PG8_LAS bf16x8*)(lds + PG8_SA(b, h) + aoff + m * 2048 + k * 1024); } while (0)
#define PG8_LDB(dst, b, h) do { _Pragma("unroll") for (int n = 0; n < 2; ++n) _Pragma("unroll") for (int k = 0; k < 2; ++k) dst[n][k] = *(const PG8_LAS bf16x8*)(lds + PG8_SB(b, h) + boff + n * 2048 + k * 1024); } while (0)
#define PG8_MMA(ai, bj, At, Bt) do { __builtin_amdgcn_s_setprio(1); _Pragma("unroll") for (int m = 0; m < 4; ++m) _Pragma("unroll") for (int n = 0; n < 2; ++n) _Pragma("unroll") for (int k = 0; k < 2; ++k) \
        acc[ai][bj][m][n] = __builtin_amdgcn_mfma_f32_16x16x32_bf16(Bt[n][k], At[m][k], acc[ai][bj][m][n], 0, 0, 0); __builtin_amdgcn_s_setprio(0); } while (0)
#define PG8_WAIT_V(n) asm volatile("s_waitcnt vmcnt(" #n ")" ::: "memory")
#define PG8_WAIT_L(n) asm volatile("s_waitcnt lgkmcnt(" #n ")" ::: "memory")
#define PG8_BAR __builtin_amdgcn_s_barrier()
#define PG8_SCHED __builtin_amdgcn_sched_barrier(0)
    Unit cur, nxt; int ui = 0;
    if (!S.next(0, cur)) return;
    f32x4 acc[2][2][4][2];
#pragma unroll
    for (int a = 0; a < 2; ++a)
#pragma unroll
        for (int b = 0; b < 2; ++b)
#pragma unroll
            for (int m = 0; m < 4; ++m)
#pragma unroll
                for (int n = 0; n < 2; ++n) acc[a][b][m][n] = (f32x4){0.f, 0.f, 0.f, 0.f};
    bf16x8 At[4][2], B0[2][2], B1[2][2];
    const char* cA = (const char*)g.A + (size_t)cur.pm * tstepA; const char* cB = (const char*)g.Bt + (size_t)cur.pn * tstep;
    S.a_ready(cur);
    if constexpr (SP2) {
        PG8_STAGE(PG8_SB(0, 0), cB, voffB); PG8_STAGE(PG8_SB(0, 1), cB + hstep, voffB); PG8_STAGE(PG8_SA(0, 0), cA, voffA); PG8_STAGE(PG8_SA(0, 1), cA + hstepA, voffA);
        if (wr == 1) PG8_BAR;
        PG8_WAIT_V(2); PG8_BAR;
        PG8_STAGE(PG8_SB(1, 0), cB + kstep, voffB); PG8_STAGE(PG8_SA(1, 0), cA + kstep, voffA); PG8_STAGE(PG8_SB(1, 1), cB + hstep + kstep, voffB);
        PG8_WAIT_V(6); PG8_BAR;
    } else {
        PG8_STAGE(PG8_SB(0, 0), cB, voffB); PG8_STAGE(PG8_SA(0, 0), cA, voffA); PG8_STAGE(PG8_SB(0, 1), cB + hstep, voffB); PG8_STAGE(PG8_SA(0, 1), cA + hstepA, voffA);
        if (wr == 1) PG8_BAR;
        PG8_WAIT_V(4); PG8_BAR;
        PG8_STAGE(PG8_SB(1, 0), cB + kstep, voffB); PG8_STAGE(PG8_SA(1, 0), cA + kstep, voffA); PG8_STAGE(PG8_SB(1, 1), cB + hstep + kstep, voffB);
        PG8_WAIT_V(6); PG8_BAR;
    }
    for (;;) {
        const bool has_next = S.next(ui + 1, nxt);
        const char* nA = has_next ? (const char*)g.A + (size_t)nxt.pm * tstepA : cA; const char* nB = has_next ? (const char*)g.Bt + (size_t)nxt.pn * tstep : cB;
        for (int t = 0; t < nt; t += 2) {
            const bool last = (t == nt - 2);
            if constexpr (Epi::MID_T >= 0) { if (t == Epi::MID_T) E.mid(acc, cur, wr, fr); }
            const char* a1 = cA + (size_t)(t + 1) * kstep;
            const char* a2 = last ? nA : cA + (size_t)(t + 2) * kstep; const char* b2 = last ? nB : cB + (size_t)(t + 2) * kstep;
            const char* a3 = a2 + kstep; const char* b3 = b2 + kstep;
            if (last && has_next) S.a_ready(nxt);
            if constexpr (SP2) {
            PG8_LDB(B0, 0, 0); PG8_LDB(B1, 0, 1); PG8_SCHED; PG8_LDA(At, 0, 0); PG8_STAGE(PG8_SA(1, 1), a1 + hstepA, voffA);
            PG8_WAIT_V(8); PG8_WAIT_L(0); PG8_BAR; PG8_MMA(0, 0, At, B0); PG8_MMA(0, 1, At, B1); PG8_BAR; PG8_SCHED;
            PG8_LDA(At, 0, 1); PG8_STAGE(PG8_SB(0, 0), b2, voffB); PG8_STAGE(PG8_SB(0, 1), b2 + hstep, voffB); PG8_STAGE(PG8_SA(0, 0), a2, voffA);
            PG8_WAIT_V(8); PG8_WAIT_L(0); PG8_BAR; PG8_MMA(1, 0, At, B0); PG8_MMA(1, 1, At, B1); PG8_BAR; PG8_SCHED;
            PG8_LDB(B0, 1, 0); PG8_LDB(B1, 1, 1); PG8_SCHED; PG8_LDA(At, 1, 0); PG8_STAGE(PG8_SA(0, 1), a2 + hstepA, voffA);
            PG8_WAIT_V(8); PG8_WAIT_L(0); PG8_BAR; PG8_MMA(0, 0, At, B0); PG8_MMA(0, 1, At, B1); PG8_BAR; PG8_SCHED;
            PG8_LDA(At, 1, 1); PG8_STAGE(PG8_SB(1, 0), b3, voffB); PG8_STAGE(PG8_SB(1, 1), b3 + hstep, voffB); PG8_STAGE(PG8_SA(1, 0), a3, voffA);
            PG8_WAIT_V(8); PG8_WAIT_L(0); PG8_BAR; PG8_MMA(1, 0, At, B0); PG8_MMA(1, 1, At, B1); PG8_BAR; PG8_SCHED;
            } else {
            PG8_LDB(B0, 0, 0); PG8_SCHED; PG8_LDA(At, 0, 0); PG8_STAGE(PG8_SA(1, 1), a1 + hstepA, voffA);
            PG8_WAIT_L(8); PG8_BAR; PG8_WAIT_L(0); PG8_MMA(0, 0, At, B0); PG8_BAR; PG8_SCHED;
            PG8_LDB(B1, 0, 1); PG8_STAGE(PG8_SB(0, 0), b2, voffB);
            PG8_BAR; PG8_WAIT_L(0); PG8_MMA(0, 1, At, B1); PG8_BAR;
            PG8_LDA(At, 0, 1); PG8_STAGE(PG8_SA(0, 0), a2, voffA);
            PG8_BAR; PG8_WAIT_L(0); PG8_MMA(1, 0, At, B0); PG8_BAR; PG8_SCHED;
            PG8_STAGE(PG8_SB(0, 1), b2 + hstep, voffB);
            PG8_WAIT_V(6); PG8_BAR; PG8_MMA(1, 1, At, B1); PG8_BAR;
            PG8_LDB(B0, 1, 0); PG8_SCHED; PG8_LDA(At, 1, 0); PG8_STAGE(PG8_SA(0, 1), a2 + hstepA, voffA);
            PG8_WAIT_L(8); PG8_BAR; PG8_WAIT_L(0); PG8_MMA(0, 0, At, B0); PG8_BAR; PG8_SCHED;
            PG8_LDB(B1, 1, 1); PG8_STAGE(PG8_SB(1, 0), b3, voffB);
            PG8_BAR; PG8_WAIT_L(0); PG8_MMA(0, 1, At, B1); PG8_BAR;
            PG8_LDA(At, 1, 1); PG8_STAGE(PG8_SA(1, 0), a3, voffA);
            PG8_BAR; PG8_WAIT_L(0); PG8_MMA(1, 0, At, B0); PG8_BAR; PG8_SCHED;
            PG8_STAGE(PG8_SB(1, 1), b3 + hstep, voffB);
            PG8_WAIT_V(6); PG8_BAR; PG8_MMA(1, 1, At, B1); PG8_BAR;
            }
        }
        if constexpr (ALIGN_EPI) { if (wr == 0) PG8_BAR; }
        if constexpr (!Epi::AFTER_DRAIN) { E(acc, cur, wr, wc, fr, fq); S.done(cur); }
        if (!has_next) break;
#pragma unroll
        for (int a = 0; a < 2; ++a)
#pragma unroll
            for (int b = 0; b < 2; ++b)
#pragma unroll
                for (int m = 0; m < 4; ++m)
#pragma unroll
                    for (int n = 0; n < 2; ++n) acc[a][b][m][n] = (f32x4){0.f, 0.f, 0.f, 0.f};
        cur = nxt; cA = nA; cB = nB; ++ui;
        if constexpr (ALIGN_EPI) { if (wr == 1) PG8_BAR; }
    }
    PG8_WAIT_V(0);
    if constexpr (!ALIGN_EPI) { if (wr == 0) PG8_BAR; }
    PG8_BAR;
    if constexpr (Epi::AFTER_DRAIN) { E.fused(acc, cur, wr, wc, fr, fq, lds, wid, lane); S.done(cur); }
#undef PG8_SA
#undef PG8_SB
#undef PG8_STAGE
#undef PG8_LDA
#undef PG8_LDB
#undef PG8_MMA
#undef PG8_WAIT_V
#undef PG8_WAIT_L
#undef PG8_BAR
#undef PG8_SCHED
}
}

#define GAS __attribute__((address_space(1)))
#define LAS __attribute__((address_space(3)))
typedef unsigned short bf16;
typedef unsigned v4u __attribute__((ext_vector_type(4)));
typedef float f32x4 __attribute__((ext_vector_type(4)));
typedef short bf16x8 __attribute__((ext_vector_type(8)));
typedef GAS unsigned gu32;
typedef GAS unsigned long long gu64;
#define RLX_AGENT __ATOMIC_RELAXED, __HIP_MEMORY_SCOPE_AGENT
#define LDS_WAIT() asm volatile("s_waitcnt lgkmcnt(0)" ::: "memory")
#define VM_WAIT() asm volatile("s_waitcnt vmcnt(0)" ::: "memory")
__device__ __forceinline__ unsigned long long rt() { return __builtin_amdgcn_s_memrealtime(); }

#define XB_TMO      128
#define XB_XCNT(j)  (256  + 64 * (j))
#define XB_XSUB(j)  (1280 + 64 * (j))
#define XB_XGEN(j)  (2304 + 64 * (j))
#define XB_TOP      3328
#define XB_TOPGEN   3392
#define XCD_BAR_WORDS 3456
#define XB_SPIN_CAP (1u << 18)

__device__ __forceinline__ unsigned xb_ld(unsigned* p)              { return __hip_atomic_load(p, __ATOMIC_RELAXED, __HIP_MEMORY_SCOPE_AGENT); }
__device__ __forceinline__ unsigned xb_add(unsigned* p, unsigned v) { return __hip_atomic_fetch_add(p, v, __ATOMIC_RELAXED, __HIP_MEMORY_SCOPE_AGENT); }
__device__ __forceinline__ unsigned xb_xcc_id() { return (unsigned)__builtin_amdgcn_s_getreg((3 << 11) | 20) & 0xFu; }
#define XB_SPIN(cond, bar) do { unsigned _sp = 0; while (cond) { __builtin_amdgcn_s_sleep(1); \
    if ((++_sp & 255u) == 0u) { if (xb_ld(&(bar)[XB_TMO])) break; if (_sp > XB_SPIN_CAP) { atomicAdd(&(bar)[XB_TMO], 1u); break; } } } } while (0)

struct XcdBarrier {
    unsigned* bar; unsigned x;
    volatile LAS unsigned* st;
};

__device__ __forceinline__ XcdBarrier xcd_barrier_post(unsigned* bar, volatile LAS unsigned* st) {
    XcdBarrier b; b.bar = bar; b.x = xb_xcc_id(); b.st = st;
    if (threadIdx.x == 0) st[3] = xb_add(&bar[XB_XCNT(b.x)], 1u);
    return b;
}
__device__ __forceinline__ void xcd_barrier_complete(unsigned* bar, unsigned x, unsigned& nloc, unsigned& nx, unsigned& uni) {
    const unsigned G = gridDim.x * gridDim.y * gridDim.z;
    unsigned sum, cnt, mine, bad, sp = 0u;
    for (;;) {
        sum = 0u; cnt = 0u; mine = 0u; bad = 0u;
#pragma unroll
        for (unsigned j = 0; j < 16; ++j) { const unsigned c = xb_ld(&bar[XB_XCNT(j)]); sum += c; cnt += (c > 0u) ? 1u : 0u; mine = (j == x) ? c : mine; bad |= (c != (j < 8u ? G / 8u : 0u)) ? 1u : 0u; }
        if (sum == G) break;
        __builtin_amdgcn_s_sleep(1);
        if ((++sp & 255u) == 0u) { if (xb_ld(&bar[XB_TMO])) break; if (sp > XB_SPIN_CAP) { atomicAdd(&bar[XB_TMO], 1u); break; } }
    }
    nloc = mine > 0u ? mine : 1u; nx = cnt > 0u ? cnt : 1u;
    uni = (sum == G && (G & 7u) == 0u && bad == 0u) ? 1u : 0u;
}

__device__ __forceinline__ void xcd_barrier(const XcdBarrier& b, const bool local = false) {
    asm volatile("s_waitcnt vmcnt(0)" ::: "memory");
    __syncthreads();
    if (threadIdx.x == 0) {
        unsigned* bar = b.bar;
        __builtin_amdgcn_s_waitcnt(0);
        unsigned nloc = b.st[0], nx = b.st[1];
        if (nloc == 0u) { unsigned uni; xcd_barrier_complete(bar, b.x, nloc, nx, uni); b.st[0] = nloc; b.st[1] = nx; b.st[2] = uni; }
        const unsigned old = xb_add(&bar[XB_XSUB(b.x)], 1u);
        const unsigned gen = old / nloc;
        if (old + 1u == (gen + 1u) * nloc) {
            if (!local) {
            __builtin_amdgcn_fence(__ATOMIC_RELEASE, "agent");
            asm volatile("s_waitcnt vmcnt(0)" ::: "memory");
            const unsigned og = xb_add(&bar[XB_TOP], 1u);
            const unsigned tg = og / nx;
            if (og + 1u == (tg + 1u) * nx) xb_add(&bar[XB_TOPGEN], 1u);
            else XB_SPIN(xb_ld(&bar[XB_TOPGEN]) == tg, bar);
            }
            __builtin_amdgcn_fence(__ATOMIC_ACQUIRE, "agent");
            xb_add(&bar[XB_XGEN(b.x)], 1u);
            asm volatile("s_waitcnt vmcnt(0)" ::: "memory");
        } else {
            XB_SPIN(xb_ld(&bar[XB_XGEN(b.x)]) == gen, bar);
            __builtin_amdgcn_fence(__ATOMIC_ACQUIRE, "agent");
            asm volatile("s_waitcnt vmcnt(0)" ::: "memory");
        }
    }
    __syncthreads();
}

__device__ __forceinline__ void xcd_barrier_arrive(const XcdBarrier& b) {
    asm volatile("s_waitcnt vmcnt(0)" ::: "memory");
    __syncthreads();
    if (threadIdx.x == 0) {
        unsigned* bar = b.bar;
        __builtin_amdgcn_s_waitcnt(0);
        const unsigned nloc = b.st[0], nx = b.st[1];
        const unsigned old = xb_add(&bar[XB_XSUB(b.x)], 1u);
        const unsigned gen = old / nloc;
        if (old + 1u == (gen + 1u) * nloc) {
            xb_add(&bar[XB_XGEN(b.x)], 1u);
            __builtin_amdgcn_fence(__ATOMIC_RELEASE, "agent");
            asm volatile("s_waitcnt vmcnt(0)" ::: "memory");
            const unsigned og = xb_add(&bar[XB_TOP], 1u);
            const unsigned tg = og / nx;
            if (og + 1u == (tg + 1u) * nx) xb_add(&bar[XB_TOPGEN], 1u);
        }
    }
}
__device__ __forceinline__ void xcd_barrier_wait_global(const XcdBarrier& b, const unsigned round) {
    if (threadIdx.x == 0) {
        XB_SPIN(xb_ld(&b.bar[XB_TOPGEN]) <= round, b.bar);
        __builtin_amdgcn_fence(__ATOMIC_ACQUIRE, "agent");
        asm volatile("s_waitcnt vmcnt(0)" ::: "memory");
    }
    __syncthreads();
}
__device__ __forceinline__ void flat_arrive(unsigned* cnt) {
    __syncthreads();
    if (threadIdx.x == 0) (void)xb_add(cnt, 1u);
}
__device__ __forceinline__ void flat_wait(unsigned* cnt, const unsigned need, unsigned* bar) {
    if (threadIdx.x == 0) { XB_SPIN(xb_ld(cnt) < need, bar); }
    __syncthreads();
}

constexpr int NWAVES = 8, NTHR = NWAVES * 64;
constexpr int BATCH = 16, SEQ = 2048, DM = 1024, M = BATCH * SEQ;
constexpr int INW = 1280, AW = 512, KVW = 128, SW = 512, DFF = 2816, PLED = 256;
constexpr int NG = 32, NST = 64, TCH = 16, NCHB = SEQ / TCH;
constexpr float EPS = 1e-6f;
constexpr float LOG2E = 1.4426950408889634f;
constexpr float QSCALE = 0.125f * LOG2E;

constexpr size_t MiB = 1u << 20;
constexpr size_t WS_CTL = 0, CTL_ZERO_BYTES = 128 * 1024;
constexpr size_t WS_WIN = 1 * MiB, WS_GLU = 4 * MiB, WS_WOUT = 5 * MiB, WS_WUP = 7 * MiB, WS_WDN = 18 * MiB, WS_WPG = 24 * MiB, WS_WPP = 26 * MiB;
constexpr size_t WS_SSMG = 27 * MiB, WS_SSME = 33 * MiB, WS_AT = 35 * MiB;
constexpr size_t WS_ROPE = 36 * MiB, WS_SSQS = 38 * MiB, WS_SSQ1 = 39 * MiB, WS_SSQ2 = 41 * MiB, WS_RS1 = 43 * MiB;
constexpr size_t WS_A = 44 * MiB;
constexpr size_t WS_B = 108 * MiB;
constexpr size_t WS_C = 172 * MiB;
constexpr size_t WS_ACT = WS_C;
constexpr size_t WS_Q = WS_C, WS_K = WS_C + 32 * MiB, WS_V = WS_C + 40 * MiB, WS_U = WS_C + 48 * MiB;
constexpr size_t WS_D = 348 * MiB;
constexpr size_t WS_R = 380 * MiB;
constexpr size_t WS_END = 444 * MiB;
constexpr int CW_BAR = 4096;
constexpr int CW_ATT = 24576;
constexpr int CW_TMO = 0, CW_CNT6 = 8192;

constexpr int RING_BYTES = 131072;
constexpr int MISC_OFF = RING_BYTES + 4096;
constexpr int LDS_BYTES = 147456;

__device__ __forceinline__ float bf2f_lo(unsigned w) { return __uint_as_float(w << 16); }
__device__ __forceinline__ float bf2f_hi(unsigned w) { return __uint_as_float(w & 0xffff0000u); }
typedef float f32x2_t __attribute__((ext_vector_type(2))); typedef __bf16 bf16x2_t __attribute__((ext_vector_type(2)));
__device__ __forceinline__ unsigned pk2(float lo, float hi) { f32x2_t v = {lo, hi}; bf16x2_t b = __builtin_convertvector(v, bf16x2_t); return __builtin_bit_cast(unsigned, b); }
typedef unsigned u32x2 __attribute__((ext_vector_type(2)));
__device__ __forceinline__ float fast_exp2(float x) { return __builtin_amdgcn_exp2f(x); }
__device__ __forceinline__ float fast_rcp(float x) { return __builtin_amdgcn_rcpf(x); }
__device__ __forceinline__ float sigmoidf_fast(float v) { return fast_rcp(1.0f + fast_exp2(-LOG2E * v)); }
__device__ __forceinline__ float wave_sum(float v) {
#pragma unroll
    for (int o = 1; o < 64; o <<= 1) v += __shfl_xor(v, o);
    return v;
}
#define MFMA16(a, b, c) __builtin_amdgcn_mfma_f32_16x16x32_bf16((a), (b), (c), 0, 0, 0)

namespace pg8 {
__device__ __forceinline__ u32x4 pack8(const f32x4& a, const f32x4& b) { u32x4 w; w.x = pk2(a[0], a[1]); w.y = pk2(a[2], a[3]); w.z = pk2(b[0], b[1]); w.w = pk2(b[2], b[3]); return w; }
__device__ __forceinline__ float sq4(const f32x4& a) { return (a[0] * a[0] + a[1] * a[1]) + (a[2] * a[2] + a[3] * a[3]); }

struct EpiZ {
    static constexpr bool PERM = true, AFTER_DRAIN = false; static constexpr int MID_T = -1; static constexpr int NST = 16;
    bf16_t *Q, *K, *V, *U; const float* RS;
    __device__ __forceinline__ void operator()(const f32x4 (&acc)[2][2][4][2], const Unit& u, int wr, int wc, int fr, int fq) const {
        const int row0 = u.pm * BM + wr * 64 + fr, c8 = wc * 32 + 8 * fq;
#pragma unroll
        for (int ai = 0; ai < 2; ++ai)
#pragma unroll
            for (int m = 0; m < 4; ++m) { const size_t row = (size_t)(row0 + ai * HALF + m * 16); const float rs = RS[row];
#pragma unroll
                for (int bj = 0; bj < 2; ++bj) { const u32x4 w = pack8(acc[ai][bj][m][0] * rs, acc[ai][bj][m][1] * rs); bf16_t* dst;
                    if (u.pn < 2) dst = Q + row * 512 + u.pn * 256 + bj * HALF + c8;
                    else if (u.pn == 2) dst = (bj == 0 ? K : V) + row * 128 + c8;
                    else { const int ui = (u.pn - 3) * 256 + bj * HALF + c8; dst = U + ((size_t)(ui >> 4) * 2048 + (row >> 4)) * 384 + (row & 15) * 16 + (ui & 15); }
                    *(u32x4*)dst = w; } }
    }
};
struct EpiB16 {
    static constexpr bool PERM = true, AFTER_DRAIN = false; static constexpr int MID_T = -1; static constexpr int NST = 16;
    bf16_t* O; int ldc;
    __device__ __forceinline__ void operator()(const f32x4 (&acc)[2][2][4][2], const Unit& u, int wr, int wc, int fr, int fq) const {
        const int row0 = u.pm * BM + wr * 64 + fr, col0 = u.pn * BM + wc * 32 + 8 * fq;
#pragma unroll
        for (int ai = 0; ai < 2; ++ai)
#pragma unroll
            for (int m = 0; m < 4; ++m) { bf16_t* rowp = O + (size_t)(row0 + ai * HALF + m * 16) * ldc + col0;
#pragma unroll
                for (int bj = 0; bj < 2; ++bj) __builtin_nontemporal_store(pack8(acc[ai][bj][m][0], acc[ai][bj][m][1]), (u32x4*)(rowp + bj * HALF)); }
    }
};
__device__ __forceinline__ void unpack8v(const u32x4& w, f32x4& a, f32x4& b) { a = (f32x4){bf2f_lo(w.x), bf2f_hi(w.x), bf2f_lo(w.y), bf2f_hi(w.y)}; b = (f32x4){bf2f_lo(w.z), bf2f_hi(w.z), bf2f_lo(w.w), bf2f_hi(w.w)}; }
template <int NP> __device__ __forceinline__ void rows_rs(const float* __restrict__ SSQ, int row0, int fr, int fq, float inv_n, float (&rs)[2][4]) {
    f32x4 p[2][NP / 4];
#pragma unroll
    for (int ai = 0; ai < 2; ++ai)
#pragma unroll
        for (int j = 0; j < NP / 4; ++j) p[ai][j] = *(const f32x4*)(SSQ + (size_t)(row0 + ai * HALF + fq * 16) * NP + 4 * j);
    float own[2];
#pragma unroll
    for (int ai = 0; ai < 2; ++ai) { f32x4 t = p[ai][0];
#pragma unroll
        for (int j = 1; j < NP / 4; ++j) t += p[ai][j];
        own[ai] = rsqrtf(((t[0] + t[1]) + (t[2] + t[3])) * inv_n + EPS); }
#pragma unroll
    for (int ai = 0; ai < 2; ++ai)
#pragma unroll
        for (int m = 0; m < 4; ++m) rs[ai][m] = __shfl(own[ai], fr + 16 * m);
}
struct EpiGlu {
    static constexpr bool PERM = true, AFTER_DRAIN = false; static constexpr int MID_T = -1; static constexpr int NST = 16;
    const bf16_t* YG; const float* bias; bf16_t* MIX; float* SSQS;
    __device__ __forceinline__ void operator()(const f32x4 (&acc)[2][2][4][2], const Unit& u, int wr, int wc, int fr, int fq) const {
        const int row0 = u.pm * BM + wr * 64 + fr, col0 = u.pn * BM + wc * 32 + 8 * fq;
        u32x4 yw[2][4][2];
#define GLU_LOAD(ai) do { _Pragma("unroll") for (int m_ = 0; m_ < 4; ++m_) _Pragma("unroll") for (int bj = 0; bj < 2; ++bj) yw[ai][m_][bj] = *(const u32x4*)(YG + (size_t)(row0 + (ai) * HALF + m_ * 16) * 512 + col0 + bj * HALF); } while (0)
        GLU_LOAD(0);
        f32x4 bv[2][2];
#pragma unroll
        for (int bj = 0; bj < 2; ++bj)
#pragma unroll
            for (int n = 0; n < 2; ++n) bv[bj][n] = *(const f32x4*)(bias + col0 + bj * HALF + 4 * n);
#pragma unroll
        for (int ai = 0; ai < 2; ++ai)
#pragma unroll
            for (int m = 0; m < 4; ++m) { const size_t row = (size_t)(row0 + ai * HALF + m * 16); float ss = 0.f;
                if (ai == 0 && m == 2) GLU_LOAD(1);
#pragma unroll
                for (int bj = 0; bj < 2; ++bj) {
                    f32x4 y0, y1; unpack8v(yw[ai][m][bj], y0, y1);
                    const f32x4 v0 = acc[ai][bj][m][0] + bv[bj][0], v1 = acc[ai][bj][m][1] + bv[bj][1];
                    f32x4 s0, s1;
#pragma unroll
                    for (int i = 0; i < 4; ++i) { s0[i] = y0[i] * sigmoidf_fast(v0[i]); s1[i] = y1[i] * sigmoidf_fast(v1[i]); }
                    ss += sq4(s0) + sq4(s1);
                    *(u32x4*)(MIX + row * 1024 + col0 + bj * HALF) = pack8(s0, s1); }
                ss += __shfl_xor(ss, 16); ss += __shfl_xor(ss, 32);
                if (fq == 0) SSQS[row * 8 + u.pn * 4 + wc] = ss; }
#undef GLU_LOAD
    }
};
struct EpiH1 {
    static constexpr bool PERM = true, AFTER_DRAIN = false; static constexpr int MID_T = 8; static constexpr int NST = 16;
    const bf16_t* XB; bf16_t* HB; const float* SSQS; float* SSQ;
    __device__ __forceinline__ void mid(f32x4 (&acc)[2][2][4][2], const Unit& u, int wr, int fr) const {
        float rs[2][4]; rows_rs<8>(SSQS, u.pm * BM + wr * 64 + fr, fr, (int)(threadIdx.x & 63) >> 4, 1.0f / 512.0f, rs);
#pragma unroll
        for (int ai = 0; ai < 2; ++ai)
#pragma unroll
            for (int m = 0; m < 4; ++m)
#pragma unroll
                for (int bj = 0; bj < 2; ++bj)
#pragma unroll
                    for (int n = 0; n < 2; ++n) acc[ai][bj][m][n] *= rs[ai][m];
    }
    __device__ __forceinline__ void operator()(const f32x4 (&acc)[2][2][4][2], const Unit& u, int wr, int wc, int fr, int fq) const {
        const int row0 = u.pm * BM + wr * 64 + fr, col0 = u.pn * BM + wc * 32 + 8 * fq;
        u32x4 xw[2][4][2];
#define RES_LOAD(ai) do { _Pragma("unroll") for (int m_ = 0; m_ < 4; ++m_) _Pragma("unroll") for (int bj = 0; bj < 2; ++bj) xw[ai][m_][bj] = *(const u32x4*)(XB + (size_t)(row0 + (ai) * HALF + m_ * 16) * 1024 + col0 + bj * HALF); } while (0)
        RES_LOAD(0);
#pragma unroll
        for (int ai = 0; ai < 2; ++ai)
#pragma unroll
            for (int m = 0; m < 4; ++m) { const size_t row = (size_t)(row0 + ai * HALF + m * 16); float ss = 0.f;
                if (ai == 0 && m == 1) RES_LOAD(1);
#pragma unroll
                for (int bj = 0; bj < 2; ++bj) { const size_t off = row * 1024 + col0 + bj * HALF;
                    f32x4 x0, x1; unpack8v(xw[ai][m][bj], x0, x1);
                    const f32x4 h0 = x0 + acc[ai][bj][m][0], h1 = x1 + acc[ai][bj][m][1];
                    ss += sq4(h0) + sq4(h1);
                    *(u32x4*)(HB + off) = pack8(h0, h1); }
                ss += __shfl_xor(ss, 16); ss += __shfl_xor(ss, 32);
                if (fq == 0) SSQ[row * 16 + u.pn * 4 + wc] = ss; }
#undef RES_LOAD
    }
};
struct EpiSwiGlu {
    static constexpr bool PERM = true, AFTER_DRAIN = false; static constexpr int MID_T = -1; static constexpr int NST = 8;
    const float* SSQ; bf16_t* ACT; int tag; float own0, own1;
    __device__ __forceinline__ void operator()(const f32x4 (&acc)[2][2][4][2], const Unit& u, int wr, int wc, int fr, int fq) {
        const int row0 = u.pm * BM + wr * 64 + fr, col0 = u.pn * HALF + wc * 32 + 8 * fq;
        if (u.pm != tag) { tag = u.pm;
            f32x4 p[2][4];
#pragma unroll
            for (int ai = 0; ai < 2; ++ai)
#pragma unroll
                for (int j = 0; j < 4; ++j) p[ai][j] = *(const f32x4*)(SSQ + (size_t)(row0 + ai * HALF + fq * 16) * 16 + 4 * j);
            const f32x4 t0 = (p[0][0] + p[0][1]) + (p[0][2] + p[0][3]), t1 = (p[1][0] + p[1][1]) + (p[1][2] + p[1][3]);
            own0 = rsqrtf(((t0[0] + t0[1]) + (t0[2] + t0[3])) * (1.0f / 1024.0f) + EPS); own1 = rsqrtf(((t1[0] + t1[1]) + (t1[2] + t1[3])) * (1.0f / 1024.0f) + EPS); }
        typedef float f2 __attribute__((ext_vector_type(2)));
#pragma unroll
        for (int ai = 0; ai < 2; ++ai)
#pragma unroll
            for (int m = 0; m < 4; ++m) { const size_t row = (size_t)(row0 + ai * HALF + m * 16); const float r1 = __shfl(ai ? own1 : own0, fr + 16 * m);
                const float nl = -LOG2E * r1, r2 = r1 * r1;
                f32x4 o[2];
#pragma unroll
                for (int n = 0; n < 2; ++n)
#pragma unroll
                    for (int i = 0; i < 4; i += 2) { const f2 a = {acc[ai][0][m][n][i], acc[ai][0][m][n][i + 1]}, b = {acc[ai][1][m][n][i], acc[ai][1][m][n][i + 1]};
                        const f2 t = a * nl; f2 e = {fast_exp2(t.x), fast_exp2(t.y)}; e = e + 1.0f; const f2 r = {fast_rcp(e.x), fast_rcp(e.y)};
                        const f2 v = (a * b) * (r * r2); o[n][i] = v.x; o[n][i + 1] = v.y; }
                __builtin_nontemporal_store(pack8(o[0], o[1]), (u32x4*)(ACT + row * DFF + col0)); }
    }
};
struct EpiH2 {
    static constexpr bool PERM = true, AFTER_DRAIN = false; static constexpr int MID_T = -1; static constexpr int NST = 16;
    const bf16_t* H1; bf16_t* HB; float* SSQ;
    __device__ __forceinline__ void operator()(const f32x4 (&acc)[2][2][4][2], const Unit& u, int wr, int wc, int fr, int fq) const {
        const int row0 = u.pm * BM + wr * 64 + fr, col0 = u.pn * BM + wc * 32 + 8 * fq;
        u32x4 xw[2][4][2];
#define RES_LOAD(ai) do { _Pragma("unroll") for (int m_ = 0; m_ < 4; ++m_) _Pragma("unroll") for (int bj = 0; bj < 2; ++bj) xw[ai][m_][bj] = *(const u32x4*)(H1 + (size_t)(row0 + (ai) * HALF + m_ * 16) * 1024 + col0 + bj * HALF); } while (0)
        RES_LOAD(0);
#pragma unroll
        for (int ai = 0; ai < 2; ++ai)
#pragma unroll
            for (int m = 0; m < 4; ++m) { const size_t row = (size_t)(row0 + ai * HALF + m * 16); float ss = 0.f;
                if (ai == 0 && m == 1) RES_LOAD(1);
#pragma unroll
                for (int bj = 0; bj < 2; ++bj) { const size_t off = row * 1024 + col0 + bj * HALF;
                    f32x4 x0, x1; unpack8v(xw[ai][m][bj], x0, x1);
                    const f32x4 h0 = x0 + acc[ai][bj][m][0], h1 = x1 + acc[ai][bj][m][1];
                    ss += sq4(h0) + sq4(h1);
                    *(u32x4*)(HB + off) = pack8(h0, h1); }
                ss += __shfl_xor(ss, 16); ss += __shfl_xor(ss, 32);
                if (fq == 0) SSQ[row * 16 + u.pn * 4 + wc] = ss; }
#undef RES_LOAD
    }
};
struct EpiPle {
    static constexpr bool PERM = true, AFTER_DRAIN = false; static constexpr int MID_T = -1; static constexpr int NST = 32;
    float* OUT; const bf16_t* H2; const float* SSQ; const float* bias; const bf16_t* PP;
    __device__ __forceinline__ void operator()(const f32x4 (&acc)[2][2][4][2], const Unit& u, int wr, int wc, int fr, int fq) const {
        const int row0 = u.pm * BM + wr * 64 + fr, col0 = u.pn * BM + wc * 32 + 8 * fq;
        u32x4 hw[8][2], pw[8][2];
#define PLE_LOAD(k) do { _Pragma("unroll") for (int bj = 0; bj < 2; ++bj) { \
            const size_t off = (size_t)(row0 + ((k) >> 2) * HALF + ((k) & 3) * 16) * 1024 + col0 + bj * HALF; hw[k][bj] = *(const u32x4*)(H2 + off); pw[k][bj] = *(const u32x4*)(PP + off); } } while (0)
        PLE_LOAD(0); PLE_LOAD(1);
        float rs[2][4]; rows_rs<16>(SSQ, row0, fr, fq, 1.0f / 1024.0f, rs);
        f32x4 bv[2][2];
#pragma unroll
        for (int bj = 0; bj < 2; ++bj)
#pragma unroll
            for (int n = 0; n < 2; ++n) bv[bj][n] = *(const f32x4*)(bias + col0 + bj * HALF + 4 * n);
#pragma unroll
        for (int k = 0; k < 8; ++k) { const int ai = k >> 2, m = k & 3; const float r1 = rs[ai][m];
            if (k + 2 < 8) PLE_LOAD(k + 2);
#pragma unroll
            for (int bj = 0; bj < 2; ++bj) { const size_t off = (size_t)(row0 + ai * HALF + m * 16) * 1024 + col0 + bj * HALF;
                f32x4 h0, h1, p0, p1; unpack8v(hw[k][bj], h0, h1); unpack8v(pw[k][bj], p0, p1);
#pragma unroll
                for (int i = 0; i < 4; ++i) { h0[i] += sigmoidf_fast(acc[ai][bj][m][0][i] * r1 + bv[bj][0][i]) * p0[i]; h1[i] += sigmoidf_fast(acc[ai][bj][m][1][i] * r1 + bv[bj][1][i]) * p1[i]; }
                *(f32x4*)(OUT + off) = h0; *(f32x4*)(OUT + off + 4) = h1; }
        }
#undef PLE_LOAD
    }
};
constexpr int SSM_ROWB = 528;
struct OneUnit { int pm;
    __device__ __forceinline__ bool next(int i, Unit& u) const { if (i) return false; u.pm = pm; u.pn = 0; return true; }
    __device__ __forceinline__ void a_ready(const Unit&) const {}
    __device__ __forceinline__ void done(const Unit&) const {} };
struct EpiSend {
    static constexpr bool PERM = true, AFTER_DRAIN = true; static constexpr int MID_T = -1; static constexpr int NST = 0;
    const f32x2_t* AT; bf16_t* A2;
    __device__ __forceinline__ void fused(f32x4 (&acc)[2][2][4][2], const Unit& u, int wr, int wc, int fr, int fq, PG8_LAS unsigned char* lds, int wid, int lane) const {
#pragma unroll
        for (int ai = 0; ai < 2; ++ai)
#pragma unroll
            for (int m = 0; m < 4; ++m) { const int row = ai * HALF + wr * 64 + m * 16 + fr;
#pragma unroll
                for (int n = 0; n < 2; ++n) *(PG8_LAS f32x4*)(lds + row * SSM_ROWB + (wc * 32 + 8 * fq + 4 * n) * 4) = acc[ai][0][m][n]; }
        asm volatile("s_waitcnt lgkmcnt(0)" ::: "memory"); __builtin_amdgcn_s_barrier(); asm volatile("" ::: "memory");
        if (wid < 2) { const f32x2_t aT = AT[lane]; float cr = 0.f, ci = 0.f;
#pragma unroll 1
            for (int k0 = 0; k0 < 128; k0 += 8) { u32x2 sv[8];
#pragma unroll
                for (int i = 0; i < 8; ++i) sv[i] = *(const PG8_LAS u32x2*)(lds + (wid * 128 + k0 + i) * SSM_ROWB + lane * 8);
                asm volatile("s_waitcnt lgkmcnt(0)" ::: "memory");
#pragma unroll
                for (int i = 0; i < 8; ++i) { *(PG8_LAS unsigned*)(lds + (wid * 128 + k0 + i) * SSM_ROWB + lane * 4) = pk2(cr, ci);
                    const float sr = __uint_as_float(sv[i].x), si = __uint_as_float(sv[i].y), nr = aT.x * cr - aT.y * ci + sr, ni = aT.x * ci + aT.y * cr + si; cr = nr; ci = ni; }
                asm volatile("" ::: "memory"); } }
        asm volatile("s_waitcnt lgkmcnt(0)" ::: "memory"); __builtin_amdgcn_s_barrier(); asm volatile("" ::: "memory");
        const int tid = wid * 64 + lane;
#pragma unroll
        for (int i = 0; i < 8; ++i) { const int idx = tid + 512 * i, row = idx >> 4, ch = idx & 15;
            const u32x4 v = *(const PG8_LAS u32x4*)(lds + row * SSM_ROWB + ch * 16);
            *(u32x4*)(A2 + (size_t)(u.pm * BM + row) * 384 + 256 + ch * 8) = v; }
        asm volatile("s_waitcnt vmcnt(0) lgkmcnt(0)" ::: "memory"); __builtin_amdgcn_s_barrier(); asm volatile("" ::: "memory");
    }
};
__device__ __forceinline__ float gelu_tanh(float y) { const float z = 0.7978845608028654f * (y + 0.044715f * y * y * y); return y * fast_rcp(1.0f + fast_exp2(-2.0f * LOG2E * z)); }
struct EpiY {
    static constexpr bool PERM = true, AFTER_DRAIN = false; static constexpr int MID_T = -1; static constexpr int NST = 16;
    bf16_t* YG; int g;
    __device__ __forceinline__ void operator()(const f32x4 (&acc)[2][2][4][2], const Unit& u, int wr, int wc, int fr, int fq) const {
#pragma unroll
        for (int ai = 0; ai < 2; ++ai)
#pragma unroll
            for (int m = 0; m < 4; ++m) { const int R = u.pm * BM + ai * HALF + wr * 64 + m * 16 + fr;
#pragma unroll
                for (int bj = 0; bj < 2; ++bj) { const int idx = bj * HALF + wc * 32 + 8 * fq, tau = idx >> 4, c0 = idx & 15;
                    f32x4 y0, y1;
#pragma unroll
                    for (int i = 0; i < 4; ++i) { y0[i] = gelu_tanh(acc[ai][bj][m][0][i]); y1[i] = gelu_tanh(acc[ai][bj][m][1][i]); }
                    *(u32x4*)(YG + ((size_t)R * 16 + tau) * 512 + g * 16 + c0) = pack8(y0, y1); } }
    }
};
}

struct Args { const void* in[29]; float* out; unsigned char* ws; int ph_lo, ph_hi; };
enum { I_X = 0, I_P, I_POS, I_N1G, I_WIN, I_QG, I_KG, I_SINK, I_LRE, I_LIM, I_BRE, I_BIM, I_CRE, I_CIM, I_SD, I_LDT, I_GLUW, I_GLUB, I_AOG, I_SOG, I_WOUT, I_N2G,
       I_WG, I_WU, I_WD, I_PNG, I_WPG, I_BPG, I_WPP };

__device__ __forceinline__ void sincos_d(double x, double& s, double& c) {
    const double k = rint(x * 0.6366197723675814);
    double r = fma(-k, 1.5707963267341256, x); r = fma(-k, 6.077100506506192e-11, r);
    const double r2 = r * r;
    const double sp = r * (1.0 + r2 * (-1.0 / 6.0 + r2 * (1.0 / 120.0 + r2 * (-1.0 / 5040.0 + r2 * (1.0 / 362880.0 + r2 * (-1.0 / 39916800.0 + r2 * (1.0 / 6227020800.0)))))));
    const double cp = 1.0 + r2 * (-0.5 + r2 * (1.0 / 24.0 + r2 * (-1.0 / 720.0 + r2 * (1.0 / 40320.0 + r2 * (-1.0 / 3628800.0 + r2 * (1.0 / 479001600.0 + r2 * (-1.0 / 87178291200.0)))))));
    const int q = (int)k & 3;
    s = (q == 0) ? sp : (q == 1) ? cp : (q == 2) ? -sp : -cp;
    c = (q == 0) ? cp : (q == 1) ? -sp : (q == 2) ? -cp : sp;
}

__device__ __forceinline__ void tr_item(const float* __restrict__ W, int N, bf16* WT, int ldk, int kdst_off, const float* __restrict__ gain, int rowmul, int rowadd, int item, int lane, LAS float* scr) {
    const int nblk = N / 32, kb = item / nblk, nb = item % nblk, k0 = 64 * kb, n0 = 32 * nb;
    float w[32];
    const float* wp = W + (size_t)(k0 + (lane >> 5)) * N + n0 + (lane & 31);
#pragma unroll
    for (int i = 0; i < 32; ++i) w[i] = __builtin_nontemporal_load(wp + (size_t)(2 * i) * N);
    const int c = lane & 7;
    f32x4 g0 = {1.f, 1.f, 1.f, 1.f}, g1 = {1.f, 1.f, 1.f, 1.f};
    if (gain) { g0 = *(const f32x4*)(gain + k0 + 8 * c); g1 = *(const f32x4*)(gain + k0 + 8 * c + 4); }
#pragma unroll
    for (int i = 0; i < 32; ++i) scr[(2 * i + (lane >> 5)) * 33 + (lane & 31)] = w[i];
    LDS_WAIT(); asm volatile("" ::: "memory");
#pragma unroll
    for (int j = 0; j < 4; ++j) { const int n = (lane >> 3) + 8 * j; const LAS float* s = scr + (8 * c) * 33 + n;
        v4u o; o.x = pk2(s[0 * 33] * g0[0], s[1 * 33] * g0[1]); o.y = pk2(s[2 * 33] * g0[2], s[3 * 33] * g0[3]); o.z = pk2(s[4 * 33] * g1[0], s[5 * 33] * g1[1]); o.w = pk2(s[6 * 33] * g1[2], s[7 * 33] * g1[3]);
        const int nn = n0 + n, drow = (nn >> 7) * rowmul + (nn & 127) + rowadd;
        *(v4u*)(WT + (size_t)drow * ldk + kdst_off + k0 + 8 * c) = o; }
    LDS_WAIT(); asm volatile("" ::: "memory");
}

__device__ __forceinline__ void ssm_tables(LAS unsigned char* lds, int g, int part, const Args& a, bf16* GT, bf16* ET, f32x2_t* AT) {
    const int tid = threadIdx.x;
    LAS f32x2_t* P = (LAS f32x2_t*)lds;
    LAS f32x2_t* Bb = P + 64 * 17;
    LAS f32x2_t* Cc = Bb + 64 * 16;
    LAS float* Kt = (LAS float*)(Cc + 16 * 64);
    const float* lre = (const float*)a.in[I_LRE] + g * 64; const float* lim = (const float*)a.in[I_LIM] + g * 64;
    const float* bre = (const float*)a.in[I_BRE] + g * 1024; const float* bim = (const float*)a.in[I_BIM] + g * 1024;
    const float* cre = (const float*)a.in[I_CRE] + g * 1024; const float* cim = (const float*)a.in[I_CIM] + g * 1024;
    const float* dsk = (const float*)a.in[I_SD] + g * 16;
    const double dt = exp((double)((const float*)a.in[I_LDT])[g]);
    for (int t = tid; t < 64 * 17; t += NTHR) { const int n = t / 17, d = t % 17;
        const double lr = fmin((double)lre[n], -1e-4), li = (double)lim[n];
        const double mag = exp(lr * dt * (double)d), ang = li * dt * (double)d; double sn, cs; sincos_d(ang, sn, cs);
        P[t] = (f32x2_t){(float)(mag * cs), (float)(mag * sn)}; }
    for (int t = tid; t < 1024; t += NTHR) { const int n = t / 16;
        const double lr = fmin((double)lre[n], -1e-4), li = (double)lim[n];
        const double mag = exp(lr * dt), ang = li * dt; double sn, cs; sincos_d(ang, sn, cs);
        const double nr = mag * cs - 1.0, ni = mag * sn, den = lr * lr + li * li;
        const double fr = (nr * lr + ni * li) / den, fi = (ni * lr - nr * li) / den, br = (double)bre[t], bi = (double)bim[t];
        Bb[t] = (f32x2_t){(float)(fr * br - fi * bi), (float)(fr * bi + fi * br)};
        Cc[t] = (f32x2_t){cre[t], cim[t]}; }
    __syncthreads();
    {
      const int lane = tid & 63, wv = tid >> 6, cl = lane & 15, kq = lane >> 4;
#pragma unroll
      for (int dd = 0; dd < 2; ++dd) { const int d = 2 * wv + dd; f32x4 kacc = {0.f, 0.f, 0.f, 0.f};
#pragma unroll 4
          for (int st = 0; st < 32; ++st) { const int k = 4 * st + kq, n = k >> 1, ri = k & 1;
              const f32x2_t cc = Cc[cl * 64 + n], pp = P[n * 17 + d], bb = Bb[n * 16 + cl];
              const float av = ri ? -(cc.x * pp.y + cc.y * pp.x) : (cc.x * pp.x - cc.y * pp.y), bv = ri ? bb.y : bb.x;
              kacc = __builtin_amdgcn_mfma_f32_16x16x4f32(av, bv, kacc, 0, 0, 0); }
#pragma unroll
          for (int r = 0; r < 4; ++r) { const int c = 4 * kq + r; float v = kacc[r]; if (d == 0 && c == cl) v += dsk[c]; Kt[d * 256 + c * 16 + cl] = v; } } }
    __syncthreads();
    bf16* Gg = GT + (size_t)g * 256 * 384; bf16* Eg = ET + (size_t)g * 32768; bf16* Fg = Gg + 256;
    for (int q = tid; q < 1024; q += NTHR) { const int row = q >> 5, tau = 2 * part + (row >> 4), c = row & 15, col0 = (q & 31) * 8, j = col0 >> 4, c0 = col0 & 15;
        float v[8];
#pragma unroll
        for (int i = 0; i < 8; ++i) v[i] = (j <= tau) ? Kt[((tau - j) & 15) * 256 + c * 16 + c0 + i] : 0.f;
        v4u o; o.x = pk2(v[0], v[1]); o.y = pk2(v[2], v[3]); o.z = pk2(v[4], v[5]); o.w = pk2(v[6], v[7]);
        *(v4u*)(Gg + (size_t)(tau * 16 + c) * 384 + col0) = o; }
    { const int row = tid >> 5, np = 16 * part + row, n = np >> 1, ri = np & 1, col0 = (tid & 31) * 8, j = col0 >> 4, c0 = col0 & 15;
        const f32x2_t pp = P[n * 17 + (15 - j)]; float v[8];
#pragma unroll
        for (int i = 0; i < 8; ++i) { const f32x2_t bb = Bb[n * 16 + c0 + i]; v[i] = ri ? (pp.x * bb.y + pp.y * bb.x) : (pp.x * bb.x - pp.y * bb.y); }
        v4u o; o.x = pk2(v[0], v[1]); o.y = pk2(v[2], v[3]); o.z = pk2(v[4], v[5]); o.w = pk2(v[6], v[7]);
        *(v4u*)(Eg + (size_t)np * 256 + col0) = o; }
    { const int row = tid >> 4, tau = 2 * part + (row >> 4), c = row & 15, col0 = (tid & 15) * 8; float v[8];
#pragma unroll
        for (int i = 0; i < 8; ++i) { const int n = (col0 + i) >> 1, ri = (col0 + i) & 1; const f32x2_t cc = Cc[c * 64 + n], pp = P[n * 17 + tau + 1];
            v[i] = ri ? -(cc.x * pp.y + cc.y * pp.x) : (cc.x * pp.x - cc.y * pp.y); }
        v4u o; o.x = pk2(v[0], v[1]); o.y = pk2(v[2], v[3]); o.z = pk2(v[4], v[5]); o.w = pk2(v[6], v[7]);
        *(v4u*)(Fg + (size_t)(tau * 16 + c) * 384 + col0) = o; }
    if (part == 0 && tid < 64) AT[g * 64 + tid] = P[tid * 17 + 16];
    __syncthreads();
}

constexpr int I_IN = 16 * 40, I_GL = 8 * 16, I_OA = 8 * 32, I_OS = 8 * 32, I_G = 16 * 88, I_U = 16 * 88, I_D = 44 * 32, I_PG_ = 16 * 32, I_PP_ = 4 * 32;
constexpr int NITEMS = I_IN + I_GL + I_OA + I_OS + I_G + I_U + I_D + I_PG_ + I_PP_;
constexpr int NITEMS_P1 = I_IN + I_PP_;
#ifndef DEFER_T
#define DEFER_T 1
#endif
__device__ __forceinline__ void p0_tr_any(const Args& a, unsigned char* ws, int it, int lane, LAS float* scr) {
    do {
                int r = it;
                if (r < I_IN) { tr_item((const float*)a.in[I_WIN], INW, (bf16*)(ws + WS_WIN), 1024, 0, (const float*)a.in[I_N1G], 128, 0, r, lane, scr); break; } r -= I_IN;
                if (r < I_GL) { tr_item((const float*)a.in[I_GLUW], 512, (bf16*)(ws + WS_GLU), 512, 0, nullptr, 128, 0, r, lane, scr); break; } r -= I_GL;
                if (r < I_OA) { tr_item((const float*)a.in[I_WOUT], 1024, (bf16*)(ws + WS_WOUT), 1024, 512, (const float*)a.in[I_AOG], 128, 0, r, lane, scr); break; } r -= I_OA;
                if (r < I_OS) { tr_item((const float*)a.in[I_WOUT] + 512 * 1024, 1024, (bf16*)(ws + WS_WOUT), 1024, 0, (const float*)a.in[I_SOG], 128, 0, r, lane, scr); break; } r -= I_OS;
                if (r < I_G) { tr_item((const float*)a.in[I_WG], DFF, (bf16*)(ws + WS_WUP), 1024, 0, (const float*)a.in[I_N2G], 256, 0, r, lane, scr); break; } r -= I_G;
                if (r < I_U) { tr_item((const float*)a.in[I_WU], DFF, (bf16*)(ws + WS_WUP), 1024, 0, (const float*)a.in[I_N2G], 256, 128, r, lane, scr); break; } r -= I_U;
                if (r < I_D) { tr_item((const float*)a.in[I_WD], 1024, (bf16*)(ws + WS_WDN), DFF, 0, nullptr, 128, 0, r, lane, scr); break; } r -= I_D;
                if (r < I_PG_) { tr_item((const float*)a.in[I_WPG], 1024, (bf16*)(ws + WS_WPG), 1024, 0, (const float*)a.in[I_PNG], 128, 0, r, lane, scr); break; } r -= I_PG_;
                tr_item((const float*)a.in[I_WPP], 1024, (bf16*)(ws + WS_WPP), 256, 0, nullptr, 128, 0, r, lane, scr);
    } while (0);
}
__device__ __forceinline__ void p0_deferred(LAS unsigned char* lds, const Args& a, int vcu, int G) {
    const int lane = threadIdx.x & 63, wave = __builtin_amdgcn_readfirstlane(threadIdx.x >> 6);
    LAS float* scr = (LAS float*)(lds + wave * 16384);
    for (int it0 = vcu * NWAVES + wave; it0 < NITEMS - NITEMS_P1; it0 += G * NWAVES) p0_tr_any(a, a.ws, it0 + I_IN, lane, scr);
}
__device__ __forceinline__ void p0_prologue(LAS unsigned char* lds, const Args& a, int vcu, int G) {
    const int tid = threadIdx.x, lane = tid & 63, wave = __builtin_amdgcn_readfirstlane(tid >> 6);
    unsigned char* ws = a.ws;
    LAS float* scr = (LAS float*)(lds + wave * 16384);
    const int gw = vcu * NWAVES + wave, NGW = G * NWAVES;
    const int tpos = vcu & 3;
#pragma unroll
    for (int sx = 0; sx < 4; ++sx) {
        const int st = sx < tpos ? sx : sx - 1;
        if (sx == tpos) { __syncthreads();
            for (int u = vcu; u < NG * 8; u += G) ssm_tables(lds, u >> 3, u & 7, a, (bf16*)(ws + WS_SSMG), (bf16*)(ws + WS_SSME), (f32x2_t*)(ws + WS_AT));
            continue; }
        const int task = (wave < 4) ? st : (st + 1) % 3;
        if (task == 0) {
            for (int it0 = gw; it0 < (DEFER_T ? NITEMS_P1 : NITEMS); it0 += NGW)
                p0_tr_any(a, ws, DEFER_T ? (it0 < I_IN ? it0 : it0 - I_IN + (NITEMS - I_PP_)) : it0, lane, scr);
        } else if (task == 1) {
            const float* x = (const float*)a.in[I_X]; bf16* XB = (bf16*)(ws + WS_R); float* RS1 = (float*)(ws + WS_RS1);
            const int nst = (M / 2 - gw + NGW - 1) / NGW;
            f32x4 va[2][4], vb[2][4];
#pragma unroll
            for (int r = 0; r < 2; ++r) { const f32x4* xr = (const f32x4*)(x + (size_t)(gw * 2 + r) * DM) + lane;
#pragma unroll
                for (int j = 0; j < 4; ++j) va[r][j] = __builtin_nontemporal_load(xr + 64 * j); }
#define XB_STEP(CUR, NXT, it) do { const int m0 = (gw + (it) * NGW) * 2; \
                if ((it) + 1 < nst) { _Pragma("unroll") for (int r = 0; r < 2; ++r) { const f32x4* xr = (const f32x4*)(x + (size_t)(m0 + NGW * 2 + r) * DM) + lane; \
                    _Pragma("unroll") for (int j = 0; j < 4; ++j) NXT[r][j] = __builtin_nontemporal_load(xr + 64 * j); } } \
                _Pragma("unroll") for (int r = 0; r < 2; ++r) { float s2 = 0.f; \
                    _Pragma("unroll") for (int j = 0; j < 4; ++j) { const f32x4 t = CUR[r][j]; s2 += (t.x * t.x + t.y * t.y) + (t.z * t.z + t.w * t.w); } \
                    s2 = wave_sum(s2); \
                    if (lane == 0) RS1[m0 + r] = rsqrtf(s2 * (1.f / DM) + EPS); \
                    unsigned long long* o8 = (unsigned long long*)(XB + (size_t)(m0 + r) * DM) + lane; \
                    _Pragma("unroll") for (int j = 0; j < 4; ++j) { const f32x4 t = CUR[r][j]; o8[64 * j] = (unsigned long long)pk2(t.x, t.y) | ((unsigned long long)pk2(t.z, t.w) << 32); } } } while (0)
#pragma unroll 1
            for (int i2 = 0; i2 < nst; i2 += 2) { XB_STEP(va, vb, i2); if (i2 + 1 < nst) XB_STEP(vb, va, i2 + 1); }
#undef XB_STEP
        } else {
            const int gt = gw * 64 + lane, NGT = NGW * 64;
            const f32x4* p4 = (const f32x4*)a.in[I_P]; v4u* pb = (v4u*)(ws + WS_D);
            for (int i0 = gt; i0 < M * PLED / 8; i0 += NGT * 4) { f32x4 v0[4], v1[4];
#pragma unroll
                for (int q = 0; q < 4; ++q) { const int i = i0 + q * NGT; if (i < M * PLED / 8) { v0[q] = __builtin_nontemporal_load(p4 + 2 * i); v1[q] = __builtin_nontemporal_load(p4 + 2 * i + 1); } }
#pragma unroll
                for (int q = 0; q < 4; ++q) { const int i = i0 + q * NGT; if (i < M * PLED / 8) { v4u o; o.x = pk2(v0[q].x, v0[q].y); o.y = pk2(v0[q].z, v0[q].w); o.z = pk2(v1[q].x, v1[q].y); o.w = pk2(v1[q].z, v1[q].w); pb[i] = o; } } }
            const int* pos = (const int*)a.in[I_POS]; float* rope = (float*)(ws + WS_ROPE);
            for (int i = gt; i < M * 8; i += NGT) { const int tok = i >> 3, k = i & 7;
                const double inv = (k == 0) ? 1.0 : (k == 1) ? 0.19392274474868576 : (k == 2) ? 0.03760603093086393 : (k == 3) ? 0.007292664737217109 : (k == 4) ? 0.001414213562373095
                                 : (k == 5) ? 0.0002742481756762073 : (k == 6) ? 5.318295896944988e-05 : 1.031338537721246e-05;
                double sn, cs; sincos_d((double)pos[tok] * inv, sn, cs); rope[tok * 16 + k] = (float)cs; rope[tok * 16 + 8 + k] = (float)sn; }
        }
    }
}

constexpr int ATT_KSTR = 144, ATT_VSTR = 160;
constexpr int ATT_KN = 0, ATT_V = 2 * 192 * ATT_KSTR, ATT_SSQ = ATT_V + 2 * 192 * ATT_VSTR, ATT_END = ATT_SSQ + 8 * 64 * 4;
static_assert(ATT_END <= RING_BYTES, "attention LDS");
typedef short v4i16_t __attribute__((ext_vector_type(4)));
__device__ __forceinline__ u32x2 lds_tr16(const LAS unsigned char* p) { return __builtin_bit_cast(u32x2, __builtin_amdgcn_ds_read_tr16_b64_v4i16((LAS v4i16_t*)p)); }
__device__ __forceinline__ void unpack8(const v4u& w, float (&v)[8]) { v[0] = bf2f_lo(w.x); v[1] = bf2f_hi(w.x); v[2] = bf2f_lo(w.y); v[3] = bf2f_hi(w.y); v[4] = bf2f_lo(w.z); v[5] = bf2f_hi(w.z); v[6] = bf2f_lo(w.w); v[7] = bf2f_hi(w.w); }
__device__ __forceinline__ v4u pack8f(const float (&v)[8]) { v4u w; w.x = pk2(v[0], v[1]); w.y = pk2(v[2], v[3]); w.z = pk2(v[4], v[5]); w.w = pk2(v[6], v[7]); return w; }
__device__ __forceinline__ float max3f(float a, float b, float c) { float r; asm("v_max3_f32 %0, %1, %2, %3" : "=v"(r) : "v"(a), "v"(b), "v"(c)); return r; }
__device__ __forceinline__ void attn_unit(LAS unsigned char* lds, int b, int c, bool first, const bf16* __restrict__ Q, const bf16* __restrict__ Kb, const bf16* __restrict__ Vb, const float* __restrict__ rope,
                                          const float* __restrict__ gq, const float* __restrict__ gk, const float* __restrict__ sinks, bf16* MIX) {
    const int tid = threadIdx.x, lane = tid & 63, wid = __builtin_amdgcn_readfirstlane(tid >> 6);
    const int hq = wid, kvh = wid >> 2, fr = lane & 15, quad = lane >> 4;
    v4u qraw[4][2];
#pragma unroll
    for (int qt = 0; qt < 4; ++qt) { const bf16* qp = Q + ((size_t)b * SEQ + c * 64 + qt * 16 + fr) * 512 + hq * 64 + quad * 8; qraw[qt][0] = __builtin_nontemporal_load((const v4u*)qp); qraw[qt][1] = __builtin_nontemporal_load((const v4u*)(qp + 32)); }
    { const int sub = tid & 7;
      f32x4 gk0 = *(const f32x4*)(gk + sub * 8), gk1 = *(const f32x4*)(gk + sub * 8 + 4);
      const int nch = first ? 3 : 1, ngrp = first ? 2 : 1, gsz = first ? 3 : 2;
#pragma unroll 1
      for (int grp = 0; grp < ngrp; ++grp) {
          v4u kr[3], vr[3]; f32x4 cs[3][4]; int lrow[3];
#pragma unroll
          for (int i = 0; i < 3; ++i) { const int p = (grp * gsz + i) * 64 + (tid >> 3), kvh2 = p / (64 * nch), r = p % (64 * nch), x = (first ? c - 2 + (r >> 6) : c), slot = (x + 3) % 3;
              const long tok = (long)b * SEQ + x * 64 + (r & 63);
              lrow[i] = kvh2 * 192 + slot * 64 + (r & 63);
              kr[i] = (v4u){0u, 0u, 0u, 0u}; vr[i] = (v4u){0u, 0u, 0u, 0u};
#pragma unroll
              for (int j = 0; j < 4; ++j) cs[i][j] = (f32x4){0.f, 0.f, 0.f, 0.f};
              if (i < gsz && x >= 0) { kr[i] = *(const v4u*)(Kb + tok * 128 + kvh2 * 64 + sub * 8); vr[i] = *(const v4u*)(Vb + tok * 128 + kvh2 * 64 + sub * 8);
                  if (sub < 2) {
#pragma unroll
                      for (int j = 0; j < 4; ++j) cs[i][j] = *(const f32x4*)(rope + tok * 16 + 4 * j); } } }
#pragma unroll
          for (int i = 0; i < 3; ++i) { if (i < gsz) {
              float v[8]; unpack8(kr[i], v);
              float ss = 0.f;
#pragma unroll
              for (int e = 0; e < 8; ++e) ss += v[e] * v[e];
              ss += __shfl_xor(ss, 1); ss += __shfl_xor(ss, 2); ss += __shfl_xor(ss, 4);
              const float rs = rsqrtf(ss * (1.f / 64.f) + EPS);
              float o[8];
#pragma unroll
              for (int e = 0; e < 8; ++e) { v[e] *= rs * (e < 4 ? gk0[e] : gk1[e - 4]); o[e] = __shfl_xor(v[e], 1); }
              if (sub < 2) {
#pragma unroll
                  for (int e = 0; e < 8; ++e) { const float cv = cs[i][e >> 2][e & 3], sv = cs[i][2 + (e >> 2)][e & 3]; v[e] = (sub == 0) ? (v[e] * cv - o[e] * sv) : (o[e] * sv + v[e] * cv); } }
              *(LAS v4u*)(lds + ATT_KN + lrow[i] * ATT_KSTR + sub * 16) = pack8f(v);
              *(LAS v4u*)(lds + ATT_V + lrow[i] * ATT_VSTR + sub * 16) = vr[i]; } } } }
    bf16x8 qf[4][2];
    { f32x4 cs[4][4];
#pragma unroll
      for (int qt = 0; qt < 4; ++qt)
#pragma unroll
          for (int j = 0; j < 4; ++j) cs[qt][j] = (quad < 2) ? *(const f32x4*)(rope + ((size_t)b * SEQ + c * 64 + qt * 16 + fr) * 16 + 4 * j) : (f32x4){0.f, 0.f, 0.f, 0.f};
      const f32x4 g00 = *(const f32x4*)(gq + quad * 8), g01 = *(const f32x4*)(gq + quad * 8 + 4), g10 = *(const f32x4*)(gq + 32 + quad * 8), g11 = *(const f32x4*)(gq + 32 + quad * 8 + 4);
#pragma unroll
      for (int qt = 0; qt < 4; ++qt) { float v0[8], v1[8]; unpack8(qraw[qt][0], v0); unpack8(qraw[qt][1], v1);
          float ss = 0.f;
#pragma unroll
          for (int e = 0; e < 8; ++e) ss += v0[e] * v0[e] + v1[e] * v1[e];
          ss += __shfl_xor(ss, 16); ss += __shfl_xor(ss, 32);
          const float rs = rsqrtf(ss * (1.f / 64.f) + EPS) * QSCALE;
          float o[8];
#pragma unroll
          for (int e = 0; e < 8; ++e) { v0[e] *= rs * (e < 4 ? g00[e] : g01[e - 4]); v1[e] *= rs * (e < 4 ? g10[e] : g11[e - 4]); o[e] = __shfl_xor(v0[e], 16); }
          if (quad < 2) {
#pragma unroll
              for (int e = 0; e < 8; ++e) { const float cv = cs[qt][e >> 2][e & 3], sv = cs[qt][2 + (e >> 2)][e & 3]; v0[e] = (quad == 0) ? (v0[e] * cv - o[e] * sv) : (o[e] * sv + v0[e] * cv); } }
          qf[qt][0] = __builtin_bit_cast(bf16x8, pack8f(v0)); qf[qt][1] = __builtin_bit_cast(bf16x8, pack8f(v1)); } }
    __syncthreads();
    const float sink2 = sinks[hq] * LOG2E;
    bool sv[3];
#pragma unroll
    for (int sl = 0; sl < 3; ++sl) sv[sl] = (c - ((c - sl) % 3 + 3) % 3) >= 0;
    LAS float* ssq = (LAS float*)(lds + ATT_SSQ);
    f32x4 O[4][4];
    const LAS unsigned char* kbase = lds + ATT_KN + (kvh * 192 + fr) * ATT_KSTR + quad * 16;
    const LAS unsigned char* vbase = lds + ATT_V + (kvh * 192 + 4 * quad + (fr >> 2)) * ATT_VSTR + (fr & 3) * 8;
#pragma unroll
    for (int qt = 0; qt < 4; ++qt) {
        f32x4 S[12];
#pragma unroll
        for (int kt = 0; kt < 12; ++kt) {
            const bf16x8 a0 = *(const LAS bf16x8*)(kbase + kt * 16 * ATT_KSTR), a1 = *(const LAS bf16x8*)(kbase + kt * 16 * ATT_KSTR + 64);
            f32x4 sacc = {0.f, 0.f, 0.f, 0.f}; sacc = MFMA16(a0, qf[qt][0], sacc); sacc = MFMA16(a1, qf[qt][1], sacc); S[kt] = sacc; }
        float mx = -1e30f;
#pragma unroll
        for (int kt = 0; kt < 12; ++kt) if (sv[kt >> 2]) mx = max3f(mx, max3f(S[kt][0], S[kt][1], S[kt][2]), S[kt][3]);
        mx = max3f(mx, __shfl_xor(mx, 16), sink2); mx = fmaxf(mx, __shfl_xor(mx, 32));
        float sum = 0.f;
#pragma unroll
        for (int kt = 0; kt < 12; ++kt)
#pragma unroll
            for (int r = 0; r < 4; ++r) { const float pz = sv[kt >> 2] ? fast_exp2(S[kt][r] - mx) : 0.f; S[kt][r] = pz; sum += pz; }
        sum += __shfl_xor(sum, 16); sum += __shfl_xor(sum, 32);
        const float inv = 1.0f / (sum + fast_exp2(sink2 - mx));
#pragma unroll
        for (int dt = 0; dt < 4; ++dt) O[qt][dt] = (f32x4){0.f, 0.f, 0.f, 0.f};
#pragma unroll
        for (int s6 = 0; s6 < 6; ++s6) {
            v4u pw; pw.x = pk2(S[2 * s6][0], S[2 * s6][1]); pw.y = pk2(S[2 * s6][2], S[2 * s6][3]); pw.z = pk2(S[2 * s6 + 1][0], S[2 * s6 + 1][1]); pw.w = pk2(S[2 * s6 + 1][2], S[2 * s6 + 1][3]);
            const bf16x8 pb = __builtin_bit_cast(bf16x8, pw);
#pragma unroll
            for (int dt = 0; dt < 4; ++dt) {
                const u32x2 lo = lds_tr16(vbase + (s6 * 32) * ATT_VSTR + dt * 32), hi = lds_tr16(vbase + (s6 * 32 + 16) * ATT_VSTR + dt * 32);
                v4u aw; aw.x = lo.x; aw.y = lo.y; aw.z = hi.x; aw.w = hi.y;
                O[qt][dt] = MFMA16(__builtin_bit_cast(bf16x8, aw), pb, O[qt][dt]); } }
        float s2 = 0.f;
#pragma unroll
        for (int dt = 0; dt < 4; ++dt) { O[qt][dt] *= inv; s2 += (O[qt][dt][0] * O[qt][dt][0] + O[qt][dt][1] * O[qt][dt][1]) + (O[qt][dt][2] * O[qt][dt][2] + O[qt][dt][3] * O[qt][dt][3]); }
        s2 += __shfl_xor(s2, 16); s2 += __shfl_xor(s2, 32);
        if (quad == 0) ssq[hq * 64 + qt * 16 + fr] = s2;
    }
    __syncthreads();
#pragma unroll
    for (int qt = 0; qt < 4; ++qt) { const int q = qt * 16 + fr; float tot = 0.f;
#pragma unroll
        for (int h = 0; h < 8; ++h) tot += ssq[h * 64 + q];
        const float rs = rsqrtf(tot * (1.f / 512.f) + EPS);
        bf16* dst = MIX + ((size_t)b * SEQ + c * 64 + q) * 1024 + 512 + hq * 64 + 4 * quad;
#pragma unroll
        for (int dt = 0; dt < 4; ++dt) { u32x2 w; w.x = pk2(O[qt][dt][0] * rs, O[qt][dt][1] * rs); w.y = pk2(O[qt][dt][2] * rs, O[qt][dt][3] * rs); *(u32x2*)(dst + dt * 16) = w; } }
    __syncthreads();
}

static_assert(256 * pg8::SSM_ROWB <= MISC_OFF, "SSM LDS");
__device__ __forceinline__ void ssm_unit(LAS unsigned char* lds, int g, int rt, unsigned char* ws) {
    pg8::bf16_t* A2 = (pg8::bf16_t*)(ws + WS_U) + (size_t)g * 2048 * 384;
    pg8::OneUnit S{rt};
    { pg8::Gemm g1{A2, (const pg8::bf16_t*)(ws + WS_SSME) + (size_t)g * 32768, 2048, 256, 256, 384};
      pg8::EpiSend E{(const f32x2_t*)(ws + WS_AT) + g * 64, A2};
      pg8::gemm_phase<pg8::EpiSend, pg8::OneUnit, false, true>(lds, g1, S, E); }
    { pg8::Gemm g2{A2, (const pg8::bf16_t*)(ws + WS_SSMG) + (size_t)g * 256 * 384, 2048, 256, 384, 384};
      pg8::EpiY E{(pg8::bf16_t*)(ws + WS_D), g};
      pg8::gemm_phase<pg8::EpiY, pg8::OneUnit, false, true>(lds, g2, S, E); }
}

__device__ __forceinline__ void panel_publish(unsigned* cnt) {
    asm volatile("s_waitcnt vmcnt(0)" ::: "memory");
    __syncthreads();
    if (threadIdx.x == 0) { __builtin_amdgcn_fence(__ATOMIC_RELEASE, "agent"); asm volatile("s_waitcnt vmcnt(0)" ::: "memory");
        __hip_atomic_fetch_add(cnt, 1u, __ATOMIC_RELAXED, __HIP_MEMORY_SCOPE_AGENT); }
}
__device__ __forceinline__ void panel_wait(unsigned* cnt, unsigned need, unsigned* tmo) {
    if (threadIdx.x < 64) { const unsigned long long t0 = __builtin_amdgcn_s_memrealtime();
        while ((unsigned)__builtin_amdgcn_readfirstlane(__hip_atomic_load(cnt, __ATOMIC_RELAXED, __HIP_MEMORY_SCOPE_AGENT)) < need) {
            if (__builtin_amdgcn_s_memrealtime() - t0 > 2000000ull) { if (threadIdx.x == 0) __hip_atomic_store(tmo, 1u, __ATOMIC_RELAXED, __HIP_MEMORY_SCOPE_AGENT); break; }
            __builtin_amdgcn_s_sleep(2); }
        __builtin_amdgcn_fence(__ATOMIC_ACQUIRE, "agent");
        asm volatile("s_waitcnt vmcnt(0)" ::: "memory"); }
    __syncthreads();
}
namespace pg8 {
struct TileUnit { int pm, pn;
    __device__ __forceinline__ bool next(int i, Unit& u) const { if (i) return false; u.pm = pm; u.pn = pn; return true; }
    __device__ __forceinline__ void a_ready(const Unit&) const {}
    __device__ __forceinline__ void done(const Unit&) const {} };
struct ListOrder : StaticOrder { int base, cnt;
    __device__ __forceinline__ bool next(int i, Unit& u) const { if (i >= cnt) return false; StaticOrder t = *this; t.c = base + i; t.G = nwg; return t.StaticOrder::next(0, u); } };
}

__global__ void __launch_bounds__(NTHR, 2) hymba_fwd(Args args) {
    extern __shared__ __attribute__((aligned(16))) unsigned char lds_raw[];
    LAS unsigned char* lds = (LAS unsigned char*)lds_raw;
    const int tid = threadIdx.x;
    const int G = gridDim.x, bx = blockIdx.x;
    const int vcu = (G % 8 == 0) ? (bx % 8) * (G / 8) + bx / 8 : bx;
    unsigned char* ws = args.ws;
    const int lo = args.ph_lo, hi = args.ph_hi;
#if MK_N_LAUNCHES == 1
#if MK_BARRIER == 1
    volatile LAS unsigned* MISC = (volatile LAS unsigned*)(lds + MISC_OFF);
    if (tid < 32) MISC[tid] = 0u;
    __syncthreads();
    XcdBarrier bar = xcd_barrier_post((unsigned*)(ws + WS_CTL) + CW_BAR, MISC + 8);
#define GRID_BAR() xcd_barrier(bar)
#else
    cg::grid_group grid = cg::this_grid();
#define GRID_BAR() grid.sync()
#endif
#else
#define GRID_BAR() do {} while (0)
#endif
#ifndef PHASE_MASK
#define PHASE_MASK 0xff
#endif
#define IN(k) ((((PHASE_MASK) >> (k)) & 1) && lo <= (k) && (k) < hi)
#define SEAM(k) do { if (IN(k) && IN((k) + 1)) GRID_BAR(); } while (0)
#if MK_N_LAUNCHES == 1 && MK_BARRIER == 1 && !defined(NO_LOCAL_SEAMS)
#define SEAM_LOCAL(k) do { if (IN(k) && IN((k) + 1)) xcd_barrier(bar, uni); } while (0)
#else
#define SEAM_LOCAL(k) SEAM(k)
#endif
#ifndef REPEAT_PHASE
#define REPEAT_PHASE -1
#endif
#ifndef MERGE67
#define MERGE67 0
#endif
#define REP(k) for (int rep_ = 0; rep_ < ((REPEAT_PHASE == (k)) ? 2 : 1); ++rep_)
#define REPBAR() do { if (rep_) GRID_BAR(); } while (0)

    if (IN(0)) REP(0) { REPBAR(); p0_prologue(lds, args, vcu, G); }
    SEAM(0);
    int wid = bx, vwid = vcu; bool uni = false;
#if MK_N_LAUNCHES == 1 && MK_BARRIER == 1 && !defined(NO_LOCAL_SEAMS)
    if (IN(0) && IN(1)) { uni = __builtin_amdgcn_readfirstlane((int)MISC[10]) != 0;
        if (uni) { const int rank = __builtin_amdgcn_readfirstlane((int)MISC[11]); wid = rank * 8 + (int)bar.x; vwid = (int)bar.x * (G / 8) + rank; } }
#endif
    if (IN(1)) REP(1) { REPBAR();
#ifndef NO_Z
        { pg8::Gemm g{(const pg8::bf16_t*)(ws + WS_R), (const pg8::bf16_t*)(ws + WS_WIN), M, INW, DM}; pg8::StaticOrder S; S.init(M, INW, G, wid);
          pg8::EpiZ E{(pg8::bf16_t*)(ws + WS_Q), (pg8::bf16_t*)(ws + WS_K), (pg8::bf16_t*)(ws + WS_V), (pg8::bf16_t*)(ws + WS_U), (const float*)(ws + WS_RS1)};
          pg8::gemm_phase<pg8::EpiZ, pg8::StaticOrder, true, true>(lds, g, S, E); }
#endif
#ifndef NO_PP
        { pg8::Gemm g{(const pg8::bf16_t*)(ws + WS_D), (const pg8::bf16_t*)(ws + WS_WPP), M, DM, PLED}; pg8::StaticOrder S;
          pg8::EpiB16 E{(pg8::bf16_t*)(ws + WS_B), DM};
          if (G == 256) { pg8::ListOrder L; L.init(M, DM, 1, 0);
              if (wid < 128) { L.base = wid; L.cnt = 1; } else { L.base = 128 + (wid - 128) * 3; L.cnt = 3; }
              pg8::gemm_phase<pg8::EpiB16, pg8::ListOrder, true, true>(lds, g, L, E); }
          else { S.init(M, DM, G, wid); pg8::gemm_phase<pg8::EpiB16, pg8::StaticOrder, true, true>(lds, g, S, E); } }
#endif
    }
#if MK_N_LAUNCHES == 1 && MK_BARRIER == 1 && DEFER_T
    if (IN(0) && IN(1) && IN(2) && IN(3)) { xcd_barrier_arrive(bar); p0_deferred(lds, args, vcu, G); xcd_barrier_wait_global(bar, 1u); }
    else
#endif
    { if (DEFER_T && IN(1)) { __syncthreads(); p0_deferred(lds, args, vcu, G); }
      SEAM(1); }
#if MK_N_LAUNCHES == 1 && MK_BARRIER == 1 && !defined(NO_SPLIT2)
    const bool split2 = IN(2) && IN(3) && IN(4) && IN(5);
#else
    const bool split2 = false;
#endif
    if (IN(2)) {
        for (int u = vwid; u < NG * 8; u += G)
            ssm_unit(lds, u >> 3, u & 7, ws);
#if MK_N_LAUNCHES == 1 && MK_BARRIER == 1
        if (split2) xcd_barrier_arrive(bar);
#endif
        for (int u = vwid * 2; u < BATCH * 32; u += G * 2)
            for (int i = 0; i < 2; ++i) { const int uu = u + i;
                attn_unit(lds, uu >> 5, uu & 31, i == 0, (const bf16*)(ws + WS_Q), (const bf16*)(ws + WS_K), (const bf16*)(ws + WS_V), (const float*)(ws + WS_ROPE),
                          (const float*)args.in[I_QG], (const float*)args.in[I_KG], (const float*)args.in[I_SINK], (bf16*)(ws + WS_A)); }
    }
#if MK_N_LAUNCHES == 1 && MK_BARRIER == 1
    if (split2) { xcd_barrier_wait_global(bar, 2u); flat_arrive((unsigned*)(ws + WS_CTL) + CW_ATT); }
    else
#endif
    SEAM(2);
    if (IN(3)) REP(3) { REPBAR();
        pg8::Gemm g{(const pg8::bf16_t*)(ws + WS_D), (const pg8::bf16_t*)(ws + WS_GLU), M, SW, SW}; pg8::StaticOrder S; S.init(M, SW, G, wid);
        pg8::EpiGlu E{(const pg8::bf16_t*)(ws + WS_D), (const float*)args.in[I_GLUB], (pg8::bf16_t*)(ws + WS_A), (float*)(ws + WS_SSQS)};
        pg8::gemm_phase<pg8::EpiGlu, pg8::StaticOrder, true, true>(lds, g, S, E);
    }
    SEAM_LOCAL(3);
    if (IN(4)) REP(4) { REPBAR();
        pg8::Gemm g{(const pg8::bf16_t*)(ws + WS_A), (const pg8::bf16_t*)(ws + WS_WOUT), M, DM, DM}; pg8::StaticOrder S; S.init(M, DM, G, wid);
        pg8::EpiH1 E{(const pg8::bf16_t*)(ws + WS_R), (pg8::bf16_t*)(ws + WS_R), (const float*)(ws + WS_SSQS), (float*)(ws + WS_SSQ1)};
        pg8::gemm_phase<pg8::EpiH1, pg8::StaticOrder, true, true>(lds, g, S, E);
    }
    SEAM_LOCAL(4);
#if MK_N_LAUNCHES == 1 && MK_BARRIER == 1
    if (split2) flat_wait((unsigned*)(ws + WS_CTL) + CW_ATT, (unsigned)G, (unsigned*)(ws + WS_CTL) + CW_BAR);
#endif
    if (IN(5)) REP(5) { REPBAR();
        pg8::Gemm g{(const pg8::bf16_t*)(ws + WS_R), (const pg8::bf16_t*)(ws + WS_WUP), M, 2 * DFF, DM}; pg8::StaticOrder S; S.init(M, 2 * DFF, G, wid);
        pg8::EpiSwiGlu E{(const float*)(ws + WS_SSQ1), (pg8::bf16_t*)(ws + WS_ACT), -1, 0.f, 0.f};
        pg8::gemm_phase<pg8::EpiSwiGlu, pg8::StaticOrder, true, true>(lds, g, S, E);
    }
    SEAM_LOCAL(5);
    if (MERGE67 && IN(6) && IN(7) && G == 256 && (REPEAT_PHASE != 6) && (REPEAT_PHASE != 7)) {
        unsigned* ctl = (unsigned*)(ws + WS_CTL);
        pg8::StaticOrder S; S.init(M, DM, G, wid);
        pg8::Unit un0, un1; S.next(0, un0); S.next(1, un1);
        const int odd = wid & 1;
#pragma unroll 1
        for (int st = 0; st < 4; ++st) {
            const int kind = odd ? (st & 1) : (st >> 1), ui = odd ? (st >> 1) : (st & 1);
            const pg8::TileUnit T{ui ? un1.pm : un0.pm, ui ? un1.pn : un0.pn};
            if (kind == 0) {
                pg8::Gemm g{(const pg8::bf16_t*)(ws + WS_ACT), (const pg8::bf16_t*)(ws + WS_WDN), M, DM, DFF};
                pg8::EpiH2 E{(const pg8::bf16_t*)(ws + WS_R), (pg8::bf16_t*)(ws + WS_R), (float*)(ws + WS_SSQ2)};
                pg8::gemm_phase<pg8::EpiH2, pg8::TileUnit, false, true>(lds, g, T, E);
                panel_publish(ctl + CW_CNT6 + 64 * T.pm);
            } else {
                panel_wait(ctl + CW_CNT6 + 64 * T.pm, 4u, ctl + CW_TMO);
                pg8::Gemm g{(const pg8::bf16_t*)(ws + WS_R), (const pg8::bf16_t*)(ws + WS_WPG), M, DM, DM};
                pg8::EpiPle E{args.out, (const pg8::bf16_t*)(ws + WS_R), (const float*)(ws + WS_SSQ2), (const float*)args.in[I_BPG], (const pg8::bf16_t*)(ws + WS_B)};
                pg8::gemm_phase<pg8::EpiPle, pg8::TileUnit, false, true>(lds, g, T, E);
            }
        }
    } else {
    if (IN(6)) REP(6) { REPBAR();
        pg8::Gemm g{(const pg8::bf16_t*)(ws + WS_ACT), (const pg8::bf16_t*)(ws + WS_WDN), M, DM, DFF}; pg8::StaticOrder S; S.init(M, DM, G, wid);
        pg8::EpiH2 E{(const pg8::bf16_t*)(ws + WS_R), (pg8::bf16_t*)(ws + WS_R), (float*)(ws + WS_SSQ2)};
        pg8::gemm_phase<pg8::EpiH2, pg8::StaticOrder, true, true>(lds, g, S, E);
    }
    SEAM_LOCAL(6);
    if (IN(7)) REP(7) { REPBAR();
        pg8::Gemm g{(const pg8::bf16_t*)(ws + WS_R), (const pg8::bf16_t*)(ws + WS_WPG), M, DM, DM}; pg8::StaticOrder S; S.init(M, DM, G, wid);
        pg8::EpiPle E{args.out, (const pg8::bf16_t*)(ws + WS_R), (const float*)(ws + WS_SSQ2), (const float*)args.in[I_BPG], (const pg8::bf16_t*)(ws + WS_B)};
        pg8::gemm_phase<pg8::EpiPle, pg8::StaticOrder, true, true>(lds, g, S, E);
    }
    }
#undef IN
#undef SEAM
#undef SEAM_LOCAL
}

extern "C" void kernel_launch(void* const* d_in, const int* in_sizes, int n_in, void* d_out, int out_size, void* d_ws, size_t ws_size, hipStream_t stream) {
    static int grid = 0;
    if (grid == 0) {
        if (n_in != 29 || in_sizes[0] != M * DM || out_size != M * DM || ws_size < WS_END) { fprintf(stderr, "kernel_launch: unexpected shapes (n_in %d, in0 %d, out %d, ws %zu); nothing launched\n", n_in, n_in > 0 ? in_sizes[0] : -1, out_size, ws_size); grid = -1; return; }
        int dev = 0, cus = 0, per_cu = 0;
        if (hipGetDevice(&dev) != hipSuccess || hipDeviceGetAttribute(&cus, hipDeviceAttributeMultiprocessorCount, dev) != hipSuccess) { grid = -1; return; }
        if (hipFuncSetAttribute((const void*)hymba_fwd, hipFuncAttributeMaxDynamicSharedMemorySize, LDS_BYTES) != hipSuccess) { fprintf(stderr, "kernel_launch: hipFuncSetAttribute failed\n"); grid = -1; return; }
        if (hipOccupancyMaxActiveBlocksPerMultiprocessor(&per_cu, (const void*)hymba_fwd, NTHR, LDS_BYTES) != hipSuccess || per_cu < 1) { fprintf(stderr, "kernel_launch: occupancy query says %d blocks per CU\n", per_cu); per_cu = 1; }
        (void)hipGetLastError();
        grid = cus * (per_cu < 1 ? 1 : 1);
    }
    if (grid < 0) return;
    (void)hipMemsetAsync((char*)d_ws + WS_CTL, 0, CTL_ZERO_BYTES, stream);
    Args a{};
    for (int i = 0; i < 29; ++i) a.in[i] = d_in[i];
    a.out = (float*)d_out; a.ws = (unsigned char*)d_ws;
#if MK_N_LAUNCHES == 1
    a.ph_lo = 0; a.ph_hi = 8;
    void* kargs[] = {&a};
    hipError_t e = hipLaunchCooperativeKernel((const void*)hymba_fwd, dim3(grid), dim3(NTHR), kargs, LDS_BYTES, stream);
    if (e != hipSuccess) fprintf(stderr, "kernel_launch: cooperative launch failed: %s (grid %d)\n", hipGetErrorString(e), grid);
#else
    for (int ph = 0; ph < 8; ++ph) { a.ph_lo = ph; a.ph_hi = ph + 1; hipLaunchKernelGGL(hymba_fwd, dim3(grid), dim3(NTHR), LDS_BYTES, stream, a); }
#endif
}
```

```cpp
#include <hip/hip_runtime.h>
#include <hip/hip_cooperative_groups.h>
#include <cstdio>
#include <cstdint>
namespace cg = cooperative_groups;

#ifndef MK_N_LAUNCHES
#define MK_N_LAUNCHES 1
#endif
#ifndef MK_BARRIER
#define MK_BARRIER 1
#endif

namespace pg8 {
#define PG8_LAS __attribute__((address_space(3)))
typedef unsigned short bf16_t;
typedef short bf16x8 __attribute__((ext_vector_type(8)));
typedef float f32x4 __attribute__((ext_vector_type(4)));
typedef unsigned u32x4 __attribute__((ext_vector_type(4)));
constexpr int BM = 256, BK = 64, HALF = 128, HTB = HALF * BK * 2  , STAGE_BYTES = 8 * HTB, NXCD = 8, WGM = 8;

__host__ __device__ __forceinline__ int lds_byte(int r, int c) { const int st = (r >> 4) * 2 + (c >> 5), rr = r & 15, cc = c & 31, ob = rr * 64 + cc * 2; return st * 1024 + (ob ^ (((ob >> 9) & 1) << 5)); }
__host__ __device__ __forceinline__ void stage_rc(int b, int& R, int& C) { const int st = b / 1024, sb = b % 1024, swz = sb ^ (((sb >> 9) & 1) << 5); R = (st >> 1) * 16 + swz / 64; C = (st & 1) * 32 + (swz % 64) / 2; }
__host__ __device__ __forceinline__ int perm32(int rho) { const int n = rho >> 4, i = rho & 15; return 8 * (i >> 2) + 4 * n + (i & 3); }

struct Unit { int pm, pn; };
struct Gemm { const bf16_t* A; const bf16_t* Bt; int M, N, K; int lda; };

struct StaticOrder {
    int nM, nN, nwg, G, c;
    __host__ __device__ void init(int M, int N, int G_, int c_) { nM = M / BM; nN = N / BM; nwg = nM * nN; G = G_; c = c_; }
    __host__ __device__ bool next(int i, Unit& u) const {
        const long L = (long)i * G + c; if (L >= nwg) return false;
        int wgid = (int)L; { const int q = nwg / NXCD, r = nwg % NXCD, xcd = wgid % NXCD, off = wgid / NXCD; wgid = (xcd < r ? xcd * (q + 1) : r * (q + 1) + (xcd - r) * q) + off; }
        const int nig = WGM * nN, gid = wgid / nig, fm = gid * WGM, gsz = (nM - fm) < WGM ? (nM - fm) : WGM;
        u.pm = fm + ((wgid % nig) % gsz); u.pn = (wgid % nig) / gsz; return true;
    }
    __device__ __forceinline__ void a_ready(const Unit&) const {}
    __device__ __forceinline__ void done(const Unit&) const {}
};

__device__ __forceinline__ unsigned cvt_pk_bf16(float lo, float hi) { unsigned r; asm volatile("v_cvt_pk_bf16_f32 %0, %1, %2" : "=v"(r) : "v"(lo), "v"(hi)); return r; }
typedef float f32x2 __attribute__((ext_vector_type(2)));
template <class Epi, class Sched, bool ALIGN_EPI = false, bool SP2 = false>
__device__ __forceinline__ void gemm_phase(PG8_LAS unsigned char* lds, const Gemm g, const Sched& S, const Epi& E_) {
    Epi E = E_;
    const int tid = threadIdx.x, wid = __builtin_amdgcn_readfirstlane(tid >> 6), lane = tid & 63, wr = wid >> 2, wc = wid & 3, fr = lane & 15, fq = lane >> 4;
    int K_ = g.K; asm volatile("" : "+s"(K_));
    const int K = K_, nt = K / BK; int lda_ = g.lda ? g.lda : g.K; asm volatile("" : "+s"(lda_)); const int lda = lda_;
    unsigned voffA[2], voffB[2];
#pragma unroll
    for (int i = 0; i < 2; ++i) { int R, C; stage_rc(tid * 16 + i * 8192, R, C); const int Rb = Epi::PERM ? ((R & ~31) + perm32(R & 31)) : R;
        voffA[i] = (unsigned)(R * lda + C) * 2u; voffB[i] = (unsigned)(Rb * K + C) * 2u; }
    const size_t kstep = (size_t)(BK * 2);
    const size_t hstep = (size_t)HALF * K * 2;
    const size_t tstep = 2 * hstep; const size_t hstepA = (size_t)HALF * lda * 2, tstepA = 2 * hstepA;
    const unsigned ldsw = (unsigned)wid * 1024u;
    const int aoff = lds_byte(wr * 64 + fr, fq * 8), boff = lds_byte(wc * 32 + fr, fq * 8);
#define PG8_SA(b, h) (((b) * 2 + (h)) * HTB)
#define PG8_SB(b, h) ((4 + (b) * 2 + (h)) * HTB)
#define PG8_STAGE(bufoff, gbase, voff) do { _Pragma("unroll") for (int _i = 0; _i < 2; ++_i) \
        __builtin_amdgcn_global_load_lds((const unsigned*)((const char*)(gbase) + (voff)[_i]), (PG8_LAS unsigned*)(lds + (bufoff) + ldsw + _i * 8192), 16, 0, 0); } while (0)
#define PG8_LDA(dst, b, h) do { _Pragma("unroll") for (int m = 0; m < 4; ++m) _Pragma("unroll") for (int k = 0; k < 2; ++k) dst[m][k] = *(const PG8_LAS bf16x8*)(lds + PG8_SA(b, h) + aoff + m * 2048 + k * 1024); } while (0)
#define PG8_LDB(dst, b, h) do { _Pragma("unroll") for (int n = 0; n < 2; ++n) _Pragma("unroll") for (int k = 0; k < 2; ++k) dst[n][k] = *(const PG8_LAS bf16x8*)(lds + PG8_SB(b, h) + boff + n * 2048 + k * 1024); } while (0)
#define PG8_MMA(ai, bj, At, Bt) do { __builtin_amdgcn_s_setprio(1); _Pragma("unroll") for (int m = 0; m < 4; ++m) _Pragma("unroll") for (int n = 0; n < 2; ++n) _Pragma("unroll") for (int k = 0; k < 2; ++k) \
        acc[ai][bj][m][n] = __builtin_amdgcn_mfma_f32_16x16x32_bf16(Bt[n][k], At[m][k], acc[ai][bj][m][n], 0, 0, 0); __builtin_amdgcn_s_setprio(0); } while (0)
#define PG8_WAIT_V(n) asm volatile("s_waitcnt vmcnt(" #n ")" ::: "memory")
#define PG8_WAIT_L(n) asm volatile("s_waitcnt lgkmcnt(" #n ")" ::: "memory")
#define PG8_BAR __builtin_amdgcn_s_barrier()
#define PG8_SCHED __builtin_amdgcn_sched_barrier(0)
    Unit cur, nxt; int ui = 0;
    if (!S.next(0, cur)) return;
    f32x4 acc[2][2][4][2];
#pragma unroll
    for (int a = 0; a < 2; ++a)
#pragma unroll
        for (int b = 0; b < 2; ++b)
#pragma unroll
            for (int m = 0; m < 4; ++m)
#pragma unroll
                for (int n = 0; n < 2; ++n) acc[a][b][m][n] = (f32x4){0.f, 0.f, 0.f, 0.f};
    bf16x8 At[4][2], B0[2][2], B1[2][2];
    const char* cA = (const char*)g.A + (size_t)cur.pm * tstepA; const char* cB = (const char*)g.Bt + (size_t)cur.pn * tstep;
    S.a_ready(cur);
    if constexpr (SP2) {
        PG8_STAGE(PG8_SB(0, 0), cB, voffB); PG8_STAGE(PG8_SB(0, 1), cB + hstep, voffB); PG8_STAGE(PG8_SA(0, 0), cA, voffA); PG8_STAGE(PG8_SA(0, 1), cA + hstepA, voffA);
        if (wr == 1) PG8_BAR;
        PG8_WAIT_V(2); PG8_BAR;
        PG8_STAGE(PG8_SB(1, 0), cB + kstep, voffB); PG8_STAGE(PG8_SA(1, 0), cA + kstep, voffA); PG8_STAGE(PG8_SB(1, 1), cB + hstep + kstep, voffB);
        PG8_WAIT_V(6); PG8_BAR;
    } else {
        PG8_STAGE(PG8_SB(0, 0), cB, voffB); PG8_STAGE(PG8_SA(0, 0), cA, voffA); PG8_STAGE(PG8_SB(0, 1), cB + hstep, voffB); PG8_STAGE(PG8_SA(0, 1), cA + hstepA, voffA);
        if (wr == 1) PG8_BAR;
        PG8_WAIT_V(4); PG8_BAR;
        PG8_STAGE(PG8_SB(1, 0), cB + kstep, voffB); PG8_STAGE(PG8_SA(1, 0), cA + kstep, voffA); PG8_STAGE(PG8_SB(1, 1), cB + hstep + kstep, voffB);
        PG8_WAIT_V(6); PG8_BAR;
    }
    for (;;) {
        const bool has_next = S.next(ui + 1, nxt);
        const char* nA = has_next ? (const char*)g.A + (size_t)nxt.pm * tstepA : cA; const char* nB = has_next ? (const char*)g.Bt + (size_t)nxt.pn * tstep : cB;
        for (int t = 0; t < nt; t += 2) {
            const bool last = (t == nt - 2);
            if constexpr (Epi::MID_T >= 0) { if (t == Epi::MID_T) E.mid(acc, cur, wr, fr); }
            const char* a1 = cA + (size_t)(t + 1) * kstep;
            const char* a2 = last ? nA : cA + (size_t)(t + 2) * kstep; const char* b2 = last ? nB : cB + (size_t)(t + 2) * kstep;
            const char* a3 = a2 + kstep; const char* b3 = b2 + kstep;
            if (last && has_next) S.a_ready(nxt);
            if constexpr (SP2) {
            PG8_LDB(B0, 0, 0); PG8_LDB(B1, 0, 1); PG8_SCHED; PG8_LDA(At, 0, 0); PG8_STAGE(PG8_SA(1, 1), a1 + hstepA, voffA);
            PG8_WAIT_V(8); PG8_WAIT_L(0); PG8_BAR; PG8_MMA(0, 0, At, B0); PG8_MMA(0, 1, At, B1); PG8_BAR; PG8_SCHED;
            PG8_LDA(At, 0, 1); PG8_STAGE(PG8_SB(0, 0), b2, voffB); PG8_STAGE(PG8_SB(0, 1), b2 + hstep, voffB); PG8_STAGE(PG8_SA(0, 0), a2, voffA);
            PG8_WAIT_V(8); PG8_WAIT_L(0); PG8_BAR; PG8_MMA(1, 0, At, B0); PG8_MMA(1, 1, At, B1); PG8_BAR; PG8_SCHED;
            PG8_LDB(B0, 1, 0); PG8_LDB(B1, 1, 1); PG8_SCHED; PG8_LDA(At, 1, 0); PG8_STAGE(PG8_SA(0, 1), a2 + hstepA, voffA);
            PG8_WAIT_V(8); PG8_WAIT_L(0); PG8_BAR; PG8_MMA(0, 0, At, B0); PG8_MMA(0, 1, At, B1); PG8_BAR; PG8_SCHED;
            PG8_LDA(At, 1, 1); PG8_STAGE(PG8_SB(1, 0), b3, voffB); PG8_STAGE(PG8_SB(1, 1), b3 + hstep, voffB); PG8_STAGE(PG8_SA(1, 0), a3, voffA);
            PG8_WAIT_V(8); PG8_WAIT_L(0); PG8_BAR; PG8_MMA(1, 0, At, B0); PG8_MMA(1, 1, At, B1); PG8_BAR; PG8_SCHED;
            } else {
            PG8_LDB(B0, 0, 0); PG8_SCHED; PG8_LDA(At, 0, 0); PG8_STAGE(PG8_SA(1, 1), a1 + hstepA, voffA);
            PG8_WAIT_L(8); PG8_BAR; PG8_WAIT_L(0); PG8_MMA(0, 0, At, B0); PG8_BAR; PG8_SCHED;
            PG8_LDB(B1, 0, 1); PG8_STAGE(PG8_SB(0, 0), b2, voffB);
            PG8_BAR; PG8_WAIT_L(0); PG8_MMA(0, 1, At, B1); PG8_BAR;
            PG8_LDA(At, 0, 1); PG8_STAGE(PG8_SA(0, 0), a2, voffA);
            PG8_BAR; PG8_WAIT_L(0); PG8_MMA(1, 0, At, B0); PG8_BAR; PG8_SCHED;
            PG8_STAGE(PG8_SB(0, 1), b2 + hstep, voffB);
            PG8_WAIT_V(6); PG8_BAR; PG8_MMA(1, 1, At, B1); PG8_BAR;
            PG8_LDB(B0, 1, 0); PG8_SCHED; PG8_LDA(At, 1, 0); PG8_STAGE(PG8_SA(0, 1), a2 + hstepA, voffA);
            PG8_WAIT_L(8); PG8_BAR; PG8_WAIT_L(0); PG8_MMA(0, 0, At, B0); PG8_BAR; PG8_SCHED;
            PG8_LDB(B1, 1, 1); PG8_STAGE(PG8_SB(1, 0), b3, voffB);
            PG8_BAR; PG8_WAIT_L(0); PG8_MMA(0, 1, At, B1); PG8_BAR;
            PG8_LDA(At, 1, 1); PG8_STAGE(PG8_SA(1, 0), a3, voffA);
            PG8_BAR; PG8_WAIT_L(0); PG8_MMA(1, 0, At, B0); PG8_BAR; PG8_SCHED;
            PG8_STAGE(PG8_SB(1, 1), b3 + hstep, voffB);
            PG8_WAIT_V(6); PG8_BAR; PG8_MMA(1, 1, At, B1); PG8_BAR;
            }
        }
        if constexpr (ALIGN_EPI) { if (wr == 0) PG8_BAR; }
        if constexpr (!Epi::AFTER_DRAIN) { E(acc, cur, wr, wc, fr, fq); S.done(cur); }
        if (!has_next) break;
#pragma unroll
        for (int a = 0; a < 2; ++a)
#pragma unroll
            for (int b = 0; b < 2; ++b)
#pragma unroll
                for (int m = 0; m < 4; ++m)
#pragma unroll
                    for (int n = 0; n < 2; ++n) acc[a][b][m][n] = (f32x4){0.f, 0.f, 0.f, 0.f};
        cur = nxt; cA = nA; cB = nB; ++ui;
        if constexpr (ALIGN_EPI) { if (wr == 1) PG8_BAR; }
    }
    PG8_WAIT_V(0);
    if constexpr (!ALIGN_EPI) { if (wr == 0) PG8_BAR; }
    PG8_BAR;
    if constexpr (Epi::AFTER_DRAIN) { E.fused(acc, cur, wr, wc, fr, fq, lds, wid, lane); S.done(cur); }
#undef PG8_SA
#undef PG8_SB
#undef PG8_STAGE
#undef PG8_LDA
#undef PG8_LDB
#undef PG8_MMA
#undef PG8_WAIT_V
#undef PG8_WAIT_L
#undef PG8_BAR
#undef PG8_SCHED
}
}

#define GAS __attribute__((address_space(1)))
#define LAS __attribute__((address_space(3)))
typedef unsigned short bf16;
typedef unsigned v4u __attribute__((ext_vector_type(4)));
typedef float f32x4 __attribute__((ext_vector_type(4)));
typedef short bf16x8 __attribute__((ext_vector_type(8)));
typedef GAS unsigned gu32;
typedef GAS unsigned long long gu64;
#define RLX_AGENT __ATOMIC_RELAXED, __HIP_MEMORY_SCOPE_AGENT
#define LDS_WAIT() asm volatile("s_waitcnt lgkmcnt(0)" ::: "memory")
#define VM_WAIT() asm volatile("s_waitcnt vmcnt(0)" ::: "memory")
__device__ __forceinline__ unsigned long long rt() { return __builtin_amdgcn_s_memrealtime(); }

#define XB_TMO      128
#define XB_XCNT(j)  (256  + 64 * (j))
#define XB_XSUB(j)  (1280 + 64 * (j))
#define XB_XGEN(j)  (2304 + 64 * (j))
#define XB_TOP      3328
#define XB_TOPGEN   3392
#define XCD_BAR_WORDS 3456
#define XB_SPIN_CAP (1u << 18)

__device__ __forceinline__ unsigned xb_ld(unsigned* p)              { return __hip_atomic_load(p, __ATOMIC_RELAXED, __HIP_MEMORY_SCOPE_AGENT); }
__device__ __forceinline__ unsigned xb_add(unsigned* p, unsigned v) { return __hip_atomic_fetch_add(p, v, __ATOMIC_RELAXED, __HIP_MEMORY_SCOPE_AGENT); }
__device__ __forceinline__ unsigned xb_xcc_id() { return (unsigned)__builtin_amdgcn_s_getreg((3 << 11) | 20) & 0xFu; }
#define XB_SPIN(cond, bar) do { unsigned _sp = 0; while (cond) { __builtin_amdgcn_s_sleep(1); \
    if ((++_sp & 255u) == 0u) { if (xb_ld(&(bar)[XB_TMO])) break; if (_sp > XB_SPIN_CAP) { atomicAdd(&(bar)[XB_TMO], 1u); break; } } } } while (0)

struct XcdBarrier {
    unsigned* bar; unsigned x;
    volatile LAS unsigned* st;
};

__device__ __forceinline__ XcdBarrier xcd_barrier_post(unsigned* bar, volatile LAS unsigned* st) {
    XcdBarrier b; b.bar = bar; b.x = xb_xcc_id(); b.st = st;
    if (threadIdx.x == 0) st[3] = xb_add(&bar[XB_XCNT(b.x)], 1u);
    return b;
}
__device__ __forceinline__ void xcd_barrier_complete(unsigned* bar, unsigned x, unsigned& nloc, unsigned& nx, unsigned& uni) {
    const unsigned G = gridDim.x * gridDim.y * gridDim.z;
    unsigned sum, cnt, mine, bad, sp = 0u;
    for (;;) {
        sum = 0u; cnt = 0u; mine = 0u; bad = 0u;
#pragma unroll
        for (unsigned j = 0; j < 16; ++j) { const unsigned c = xb_ld(&bar[XB_XCNT(j)]); sum += c; cnt += (c > 0u) ? 1u : 0u; mine = (j == x) ? c : mine; bad |= (c != (j < 8u ? G / 8u : 0u)) ? 1u : 0u; }
        if (sum == G) break;
        __builtin_amdgcn_s_sleep(1);
        if ((++sp & 255u) == 0u) { if (xb_ld(&bar[XB_TMO])) break; if (sp > XB_SPIN_CAP) { atomicAdd(&bar[XB_TMO], 1u); break; } }
    }
    nloc = mine > 0u ? mine : 1u; nx = cnt > 0u ? cnt : 1u;
    uni = (sum == G && (G & 7u) == 0u && bad == 0u) ? 1u : 0u;
}

__device__ __forceinline__ void xcd_barrier(const XcdBarrier& b, const bool local = false) {
    asm volatile("s_waitcnt vmcnt(0)" ::: "memory");
    __syncthreads();
    if (threadIdx.x == 0) {
        unsigned* bar = b.bar;
        __builtin_amdgcn_s_waitcnt(0);
        unsigned nloc = b.st[0], nx = b.st[1];
        if (nloc == 0u) { unsigned uni; xcd_barrier_complete(bar, b.x, nloc, nx, uni); b.st[0] = nloc; b.st[1] = nx; b.st[2] = uni; }
        const unsigned old = xb_add(&bar[XB_XSUB(b.x)], 1u);
        const unsigned gen = old / nloc;
        if (old + 1u == (gen + 1u) * nloc) {
            if (!local) {
            __builtin_amdgcn_fence(__ATOMIC_RELEASE, "agent");
            asm volatile("s_waitcnt vmcnt(0)" ::: "memory");
            const unsigned og = xb_add(&bar[XB_TOP], 1u);
            const unsigned tg = og / nx;
            if (og + 1u == (tg + 1u) * nx) xb_add(&bar[XB_TOPGEN], 1u);
            else XB_SPIN(xb_ld(&bar[XB_TOPGEN]) == tg, bar);
            }
            __builtin_amdgcn_fence(__ATOMIC_ACQUIRE, "agent");
            xb_add(&bar[XB_XGEN(b.x)], 1u);
            asm volatile("s_waitcnt vmcnt(0)" ::: "memory");
        } else {
            XB_SPIN(xb_ld(&bar[XB_XGEN(b.x)]) == gen, bar);
            __builtin_amdgcn_fence(__ATOMIC_ACQUIRE, "agent");
            asm volatile("s_waitcnt vmcnt(0)" ::: "memory");
        }
    }
    __syncthreads();
}

__device__ __forceinline__ void xcd_barrier_arrive(const XcdBarrier& b) {
    asm volatile("s_waitcnt vmcnt(0)" ::: "memory");
    __syncthreads();
    if (threadIdx.x == 0) {
        unsigned* bar = b.bar;
        __builtin_amdgcn_s_waitcnt(0);
        const unsigned nloc = b.st[0], nx = b.st[1];
        const unsigned old = xb_add(&bar[XB_XSUB(b.x)], 1u);
        const unsigned gen = old / nloc;
        if (old + 1u == (gen + 1u) * nloc) {
            xb_add(&bar[XB_XGEN(b.x)], 1u);
            __builtin_amdgcn_fence(__ATOMIC_RELEASE, "agent");
            asm volatile("s_waitcnt vmcnt(0)" ::: "memory");
            const unsigned og = xb_add(&bar[XB_TOP], 1u);
            const unsigned tg = og / nx;
            if (og + 1u == (tg + 1u) * nx) xb_add(&bar[XB_TOPGEN], 1u);
        }
    }
}
__device__ __forceinline__ void xcd_barrier_wait_global(const XcdBarrier& b, const unsigned round) {
    if (threadIdx.x == 0) {
        XB_SPIN(xb_ld(&b.bar[XB_TOPGEN]) <= round, b.bar);
        __builtin_amdgcn_fence(__ATOMIC_ACQUIRE, "agent");
        asm volatile("s_waitcnt vmcnt(0)" ::: "memory");
    }
    __syncthreads();
}
__device__ __forceinline__ void flat_arrive(unsigned* cnt) {
    __syncthreads();
    if (threadIdx.x == 0) (void)xb_add(cnt, 1u);
}
__device__ __forceinline__ void flat_wait(unsigned* cnt, const unsigned need, unsigned* bar) {
    if (threadIdx.x == 0) { XB_SPIN(xb_ld(cnt) < need, bar); }
    __syncthreads();
}

constexpr int NWAVES = 8, NTHR = NWAVES * 64;
constexpr int BATCH = 16, SEQ = 2048, DM = 1024, M = BATCH * SEQ;
constexpr int INW = 1280, AW = 512, KVW = 128, SW = 512, DFF = 2816, PLED = 256;
constexpr int NG = 32, NST = 64, TCH = 16, NCHB = SEQ / TCH;
constexpr float EPS = 1e-6f;
constexpr float LOG2E = 1.4426950408889634f;
constexpr float QSCALE = 0.125f * LOG2E;

constexpr size_t MiB = 1u << 20;
constexpr size_t WS_CTL = 0, CTL_ZERO_BYTES = 128 * 1024;
constexpr size_t WS_WIN = 1 * MiB, WS_GLU = 4 * MiB, WS_WOUT = 5 * MiB, WS_WUP = 7 * MiB, WS_WDN = 18 * MiB, WS_WPG = 24 * MiB, WS_WPP = 26 * MiB;
constexpr size_t WS_SSMG = 27 * MiB, WS_SSME = 33 * MiB, WS_AT = 35 * MiB;
constexpr size_t WS_ROPE = 36 * MiB, WS_SSQS = 38 * MiB, WS_SSQ1 = 39 * MiB, WS_SSQ2 = 41 * MiB, WS_RS1 = 43 * MiB;
constexpr size_t WS_A = 44 * MiB;
constexpr size_t WS_B = 108 * MiB;
constexpr size_t WS_C = 172 * MiB;
constexpr size_t WS_ACT = WS_C;
constexpr size_t WS_Q = WS_C, WS_K = WS_C + 32 * MiB, WS_V = WS_C + 40 * MiB, WS_U = WS_C + 48 * MiB;
constexpr size_t WS_D = 348 * MiB;
constexpr size_t WS_R = 380 * MiB;
constexpr size_t WS_SSQA = 444 * MiB;
constexpr size_t WS_END = 445 * MiB;
constexpr int CW_BAR = 4096;
constexpr int CW_ATT = 24576;
constexpr int CW_TMO = 0, CW_CNT6 = 8192;

constexpr int RING_BYTES = 131072;
constexpr int MISC_OFF = RING_BYTES + 4096;
constexpr int LDS_BYTES = 147456;

__device__ __forceinline__ float bf2f_lo(unsigned w) { return __uint_as_float(w << 16); }
__device__ __forceinline__ float bf2f_hi(unsigned w) { return __uint_as_float(w & 0xffff0000u); }
typedef float f32x2_t __attribute__((ext_vector_type(2))); typedef __bf16 bf16x2_t __attribute__((ext_vector_type(2)));
__device__ __forceinline__ unsigned pk2(float lo, float hi) { f32x2_t v = {lo, hi}; bf16x2_t b = __builtin_convertvector(v, bf16x2_t); return __builtin_bit_cast(unsigned, b); }
typedef unsigned u32x2 __attribute__((ext_vector_type(2)));
__device__ __forceinline__ float fast_exp2(float x) { return __builtin_amdgcn_exp2f(x); }
__device__ __forceinline__ float fast_rcp(float x) { return __builtin_amdgcn_rcpf(x); }
__device__ __forceinline__ float sigmoidf_fast(float v) { return fast_rcp(1.0f + fast_exp2(-LOG2E * v)); }
__device__ __forceinline__ float wave_sum(float v) {
#pragma unroll
    for (int o = 1; o < 64; o <<= 1) v += __shfl_xor(v, o);
    return v;
}
#define MFMA16(a, b, c) __builtin_amdgcn_mfma_f32_16x16x32_bf16((a), (b), (c), 0, 0, 0)

namespace pg8 {
__device__ __forceinline__ u32x4 pack8(const f32x4& a, const f32x4& b) { u32x4 w; w.x = pk2(a[0], a[1]); w.y = pk2(a[2], a[3]); w.z = pk2(b[0], b[1]); w.w = pk2(b[2], b[3]); return w; }
__device__ __forceinline__ float sq4(const f32x4& a) { return (a[0] * a[0] + a[1] * a[1]) + (a[2] * a[2] + a[3] * a[3]); }

struct EpiZ {
    static constexpr bool PERM = true, AFTER_DRAIN = false; static constexpr int MID_T = -1; static constexpr int NST = 16;
    bf16_t *Q, *K, *V, *U; const float* RS;
    __device__ __forceinline__ void operator()(const f32x4 (&acc)[2][2][4][2], const Unit& u, int wr, int wc, int fr, int fq) const {
        const int row0 = u.pm * BM + wr * 64 + fr, c8 = wc * 32 + 8 * fq;
#pragma unroll
        for (int ai = 0; ai < 2; ++ai)
#pragma unroll
            for (int m = 0; m < 4; ++m) { const size_t row = (size_t)(row0 + ai * HALF + m * 16); const float rs = RS[row];
#pragma unroll
                for (int bj = 0; bj < 2; ++bj) { const u32x4 w = pack8(acc[ai][bj][m][0] * rs, acc[ai][bj][m][1] * rs); bf16_t* dst;
                    if (u.pn < 2) dst = Q + row * 512 + u.pn * 256 + bj * HALF + c8;
                    else if (u.pn == 2) dst = (bj == 0 ? K : V) + row * 128 + c8;
                    else { const int ui = (u.pn - 3) * 256 + bj * HALF + c8; dst = U + ((size_t)(ui >> 4) * 2048 + (row >> 4)) * 384 + (row & 15) * 16 + (ui & 15); }
                    *(u32x4*)dst = w; } }
    }
};
struct EpiB16 {
    static constexpr bool PERM = true, AFTER_DRAIN = false; static constexpr int MID_T = -1; static constexpr int NST = 16;
    bf16_t* O; int ldc;
    __device__ __forceinline__ void operator()(const f32x4 (&acc)[2][2][4][2], const Unit& u, int wr, int wc, int fr, int fq) const {
        const int row0 = u.pm * BM + wr * 64 + fr, col0 = u.pn * BM + wc * 32 + 8 * fq;
#pragma unroll
        for (int ai = 0; ai < 2; ++ai)
#pragma unroll
            for (int m = 0; m < 4; ++m) { bf16_t* rowp = O + (size_t)(row0 + ai * HALF + m * 16) * ldc + col0;
#pragma unroll
                for (int bj = 0; bj < 2; ++bj) __builtin_nontemporal_store(pack8(acc[ai][bj][m][0], acc[ai][bj][m][1]), (u32x4*)(rowp + bj * HALF)); }
    }
};
__device__ __forceinline__ void unpack8v(const u32x4& w, f32x4& a, f32x4& b) { a = (f32x4){bf2f_lo(w.x), bf2f_hi(w.x), bf2f_lo(w.y), bf2f_hi(w.y)}; b = (f32x4){bf2f_lo(w.z), bf2f_hi(w.z), bf2f_lo(w.w), bf2f_hi(w.w)}; }
template <int NP> __device__ __forceinline__ void rows_rs(const float* __restrict__ SSQ, int row0, int fr, int fq, float inv_n, float (&rs)[2][4]) {
    f32x4 p[2][NP / 4];
#pragma unroll
    for (int ai = 0; ai < 2; ++ai)
#pragma unroll
        for (int j = 0; j < NP / 4; ++j) p[ai][j] = *(const f32x4*)(SSQ + (size_t)(row0 + ai * HALF + fq * 16) * NP + 4 * j);
    float own[2];
#pragma unroll
    for (int ai = 0; ai < 2; ++ai) { f32x4 t = p[ai][0];
#pragma unroll
        for (int j = 1; j < NP / 4; ++j) t += p[ai][j];
        own[ai] = rsqrtf(((t[0] + t[1]) + (t[2] + t[3])) * inv_n + EPS); }
#pragma unroll
    for (int ai = 0; ai < 2; ++ai)
#pragma unroll
        for (int m = 0; m < 4; ++m) rs[ai][m] = __shfl(own[ai], fr + 16 * m);
}
struct EpiGlu {
    static constexpr bool PERM = true, AFTER_DRAIN = false; static constexpr int MID_T = -1; static constexpr int NST = 16;
    const bf16_t* YG; const float* bias; bf16_t* MIX; float* SSQS;
    __device__ __forceinline__ void operator()(const f32x4 (&acc)[2][2][4][2], const Unit& u, int wr, int wc, int fr, int fq) const {
        const int row0 = u.pm * BM + wr * 64 + fr, col0 = u.pn * BM + wc * 32 + 8 * fq;
        u32x4 yw[2][4][2];
#define GLU_LOAD(ai) do { _Pragma("unroll") for (int m_ = 0; m_ < 4; ++m_) _Pragma("unroll") for (int bj = 0; bj < 2; ++bj) yw[ai][m_][bj] = *(const u32x4*)(YG + (size_t)(row0 + (ai) * HALF + m_ * 16) * 512 + col0 + bj * HALF); } while (0)
        GLU_LOAD(0);
        f32x4 bv[2][2];
#pragma unroll
        for (int bj = 0; bj < 2; ++bj)
#pragma unroll
            for (int n = 0; n < 2; ++n) bv[bj][n] = *(const f32x4*)(bias + col0 + bj * HALF + 4 * n);
#pragma unroll
        for (int ai = 0; ai < 2; ++ai)
#pragma unroll
            for (int m = 0; m < 4; ++m) { const size_t row = (size_t)(row0 + ai * HALF + m * 16); float ss = 0.f;
                if (ai == 0 && m == 2) GLU_LOAD(1);
#pragma unroll
                for (int bj = 0; bj < 2; ++bj) {
                    f32x4 y0, y1; unpack8v(yw[ai][m][bj], y0, y1);
                    const f32x4 v0 = acc[ai][bj][m][0] + bv[bj][0], v1 = acc[ai][bj][m][1] + bv[bj][1];
                    f32x4 s0, s1;
#pragma unroll
                    for (int i = 0; i < 4; ++i) { s0[i] = y0[i] * sigmoidf_fast(v0[i]); s1[i] = y1[i] * sigmoidf_fast(v1[i]); }
                    ss += sq4(s0) + sq4(s1);
                    *(u32x4*)(MIX + row * 1024 + col0 + bj * HALF) = pack8(s0, s1); }
                ss += __shfl_xor(ss, 16); ss += __shfl_xor(ss, 32);
                if (fq == 0) SSQS[row * 8 + u.pn * 4 + wc] = ss; }
#undef GLU_LOAD
    }
};
struct EpiH1 {
    static constexpr bool PERM = true, AFTER_DRAIN = false; static constexpr int MID_T = 8; static constexpr int NST = 16;
    const bf16_t* XB; bf16_t* HB; const float* SSQS; float* SSQ; const float* SSQA;
    __device__ __forceinline__ void mid(f32x4 (&acc)[2][2][4][2], const Unit& u, int wr, int fr) const {
        float rs[2][4], ra[2][4]; rows_rs<8>(SSQS, u.pm * BM + wr * 64 + fr, fr, (int)(threadIdx.x & 63) >> 4, 1.0f / 512.0f, rs); rows_rs<8>(SSQA, u.pm * BM + wr * 64 + fr, fr, (int)(threadIdx.x & 63) >> 4, 1.0f / 512.0f, ra);
#pragma unroll
        for (int ai = 0; ai < 2; ++ai)
#pragma unroll
            for (int m = 0; m < 4; ++m) rs[ai][m] *= fast_rcp(ra[ai][m]);
#pragma unroll
        for (int ai = 0; ai < 2; ++ai)
#pragma unroll
            for (int m = 0; m < 4; ++m)
#pragma unroll
                for (int bj = 0; bj < 2; ++bj)
#pragma unroll
                    for (int n = 0; n < 2; ++n) acc[ai][bj][m][n] *= rs[ai][m];
    }
    __device__ __forceinline__ void operator()(const f32x4 (&acc)[2][2][4][2], const Unit& u, int wr, int wc, int fr, int fq) const {
        const int row0 = u.pm * BM + wr * 64 + fr, col0 = u.pn * BM + wc * 32 + 8 * fq;
        u32x4 xw[2][4][2];
#define RES_LOAD(ai) do { _Pragma("unroll") for (int m_ = 0; m_ < 4; ++m_) _Pragma("unroll") for (int bj = 0; bj < 2; ++bj) xw[ai][m_][bj] = *(const u32x4*)(XB + (size_t)(row0 + (ai) * HALF + m_ * 16) * 1024 + col0 + bj * HALF); } while (0)
        RES_LOAD(0);
        float ra[2][4]; rows_rs<8>(SSQA, row0, fr, fq, 1.0f / 512.0f, ra);
#pragma unroll
        for (int ai = 0; ai < 2; ++ai)
#pragma unroll
            for (int m = 0; m < 4; ++m) { const size_t row = (size_t)(row0 + ai * HALF + m * 16); float ss = 0.f; const float r1 = ra[ai][m];
                if (ai == 0 && m == 1) RES_LOAD(1);
#pragma unroll
                for (int bj = 0; bj < 2; ++bj) { const size_t off = row * 1024 + col0 + bj * HALF;
                    f32x4 x0, x1; unpack8v(xw[ai][m][bj], x0, x1);
                    const f32x4 h0 = x0 + acc[ai][bj][m][0] * r1, h1 = x1 + acc[ai][bj][m][1] * r1;
                    ss += sq4(h0) + sq4(h1);
                    *(u32x4*)(HB + off) = pack8(h0, h1); }
                ss += __shfl_xor(ss, 16); ss += __shfl_xor(ss, 32);
                if (fq == 0) SSQ[row * 16 + u.pn * 4 + wc] = ss; }
#undef RES_LOAD
    }
};
struct EpiSwiGlu {
    static constexpr bool PERM = true, AFTER_DRAIN = false; static constexpr int MID_T = -1; static constexpr int NST = 8;
    const float* SSQ; bf16_t* ACT; int tag; float own0, own1;
    __device__ __forceinline__ void operator()(const f32x4 (&acc)[2][2][4][2], const Unit& u, int wr, int wc, int fr, int fq) {
        const int row0 = u.pm * BM + wr * 64 + fr, col0 = u.pn * HALF + wc * 32 + 8 * fq;
        if (u.pm != tag) { tag = u.pm;
            f32x4 p[2][4];
#pragma unroll
            for (int ai = 0; ai < 2; ++ai)
#pragma unroll
                for (int j = 0; j < 4; ++j) p[ai][j] = *(const f32x4*)(SSQ + (size_t)(row0 + ai * HALF + fq * 16) * 16 + 4 * j);
            const f32x4 t0 = (p[0][0] + p[0][1]) + (p[0][2] + p[0][3]), t1 = (p[1][0] + p[1][1]) + (p[1][2] + p[1][3]);
            own0 = rsqrtf(((t0[0] + t0[1]) + (t0[2] + t0[3])) * (1.0f / 1024.0f) + EPS); own1 = rsqrtf(((t1[0] + t1[1]) + (t1[2] + t1[3])) * (1.0f / 1024.0f) + EPS); }
        typedef float f2 __attribute__((ext_vector_type(2)));
#pragma unroll
        for (int ai = 0; ai < 2; ++ai)
#pragma unroll
            for (int m = 0; m < 4; ++m) { const size_t row = (size_t)(row0 + ai * HALF + m * 16); const float r1 = __shfl(ai ? own1 : own0, fr + 16 * m);
                const float nl = -LOG2E * r1, r2 = r1 * r1;
                f32x4 o[2];
#pragma unroll
                for (int n = 0; n < 2; ++n)
#pragma unroll
                    for (int i = 0; i < 4; i += 2) { const f2 a = {acc[ai][0][m][n][i], acc[ai][0][m][n][i + 1]}, b = {acc[ai][1][m][n][i], acc[ai][1][m][n][i + 1]};
                        const f2 t = a * nl; f2 e = {fast_exp2(t.x), fast_exp2(t.y)}; e = e + 1.0f; const f2 r = {fast_rcp(e.x), fast_rcp(e.y)};
                        const f2 v = (a * b) * (r * r2); o[n][i] = v.x; o[n][i + 1] = v.y; }
                __builtin_nontemporal_store(pack8(o[0], o[1]), (u32x4*)(ACT + row * DFF + col0)); }
    }
};
struct EpiH2 {
    static constexpr bool PERM = true, AFTER_DRAIN = false; static constexpr int MID_T = -1; static constexpr int NST = 16;
    const bf16_t* H1; bf16_t* HB; float* SSQ;
    __device__ __forceinline__ void operator()(const f32x4 (&acc)[2][2][4][2], const Unit& u, int wr, int wc, int fr, int fq) const {
        const int row0 = u.pm * BM + wr * 64 + fr, col0 = u.pn * BM + wc * 32 + 8 * fq;
        u32x4 xw[2][4][2];
#define RES_LOAD(ai) do { _Pragma("unroll") for (int m_ = 0; m_ < 4; ++m_) _Pragma("unroll") for (int bj = 0; bj < 2; ++bj) xw[ai][m_][bj] = *(const u32x4*)(H1 + (size_t)(row0 + (ai) * HALF + m_ * 16) * 1024 + col0 + bj * HALF); } while (0)
        RES_LOAD(0);
#pragma unroll
        for (int ai = 0; ai < 2; ++ai)
#pragma unroll
            for (int m = 0; m < 4; ++m) { const size_t row = (size_t)(row0 + ai * HALF + m * 16); float ss = 0.f;
                if (ai == 0 && m == 1) RES_LOAD(1);
#pragma unroll
                for (int bj = 0; bj < 2; ++bj) { const size_t off = row * 1024 + col0 + bj * HALF;
                    f32x4 x0, x1; unpack8v(xw[ai][m][bj], x0, x1);
                    const f32x4 h0 = x0 + acc[ai][bj][m][0], h1 = x1 + acc[ai][bj][m][1];
                    ss += sq4(h0) + sq4(h1);
                    *(u32x4*)(HB + off) = pack8(h0, h1); }
                ss += __shfl_xor(ss, 16); ss += __shfl_xor(ss, 32);
                if (fq == 0) SSQ[row * 16 + u.pn * 4 + wc] = ss; }
#undef RES_LOAD
    }
};
struct EpiPle {
    static constexpr bool PERM = true, AFTER_DRAIN = false; static constexpr int MID_T = -1; static constexpr int NST = 32;
    float* OUT; const bf16_t* H2; const float* SSQ; const float* bias; const bf16_t* PP;
    __device__ __forceinline__ void operator()(const f32x4 (&acc)[2][2][4][2], const Unit& u, int wr, int wc, int fr, int fq) const {
        const int row0 = u.pm * BM + wr * 64 + fr, col0 = u.pn * BM + wc * 32 + 8 * fq;
        u32x4 hw[8][2], pw[8][2];
#define PLE_LOAD(k) do { _Pragma("unroll") for (int bj = 0; bj < 2; ++bj) { \
            const size_t off = (size_t)(row0 + ((k) >> 2) * HALF + ((k) & 3) * 16) * 1024 + col0 + bj * HALF; hw[k][bj] = *(const u32x4*)(H2 + off); pw[k][bj] = *(const u32x4*)(PP + off); } } while (0)
        PLE_LOAD(0); PLE_LOAD(1);
        float rs[2][4]; rows_rs<16>(SSQ, row0, fr, fq, 1.0f / 1024.0f, rs);
        f32x4 bv[2][2];
#pragma unroll
        for (int bj = 0; bj < 2; ++bj)
#pragma unroll
            for (int n = 0; n < 2; ++n) bv[bj][n] = *(const f32x4*)(bias + col0 + bj * HALF + 4 * n);
#pragma unroll
        for (int k = 0; k < 8; ++k) { const int ai = k >> 2, m = k & 3; const float r1 = rs[ai][m];
            if (k + 2 < 8) PLE_LOAD(k + 2);
#pragma unroll
            for (int bj = 0; bj < 2; ++bj) { const size_t off = (size_t)(row0 + ai * HALF + m * 16) * 1024 + col0 + bj * HALF;
                f32x4 h0, h1, p0, p1; unpack8v(hw[k][bj], h0, h1); unpack8v(pw[k][bj], p0, p1);
#pragma unroll
                for (int i = 0; i < 4; ++i) { h0[i] += sigmoidf_fast(acc[ai][bj][m][0][i] * r1 + bv[bj][0][i]) * p0[i]; h1[i] += sigmoidf_fast(acc[ai][bj][m][1][i] * r1 + bv[bj][1][i]) * p1[i]; }
                *(f32x4*)(OUT + off) = h0; *(f32x4*)(OUT + off + 4) = h1; }
        }
#undef PLE_LOAD
    }
};
constexpr int SSM_ROWB = 528;
struct OneUnit { int pm;
    __device__ __forceinline__ bool next(int i, Unit& u) const { if (i) return false; u.pm = pm; u.pn = 0; return true; }
    __device__ __forceinline__ void a_ready(const Unit&) const {}
    __device__ __forceinline__ void done(const Unit&) const {} };
struct EpiSend {
    static constexpr bool PERM = true, AFTER_DRAIN = true; static constexpr int MID_T = -1; static constexpr int NST = 0;
    const f32x2_t* AT; bf16_t* A2;
    __device__ __forceinline__ void fused(f32x4 (&acc)[2][2][4][2], const Unit& u, int wr, int wc, int fr, int fq, PG8_LAS unsigned char* lds, int wid, int lane) const {
#pragma unroll
        for (int ai = 0; ai < 2; ++ai)
#pragma unroll
            for (int m = 0; m < 4; ++m) { const int row = ai * HALF + wr * 64 + m * 16 + fr;
#pragma unroll
                for (int n = 0; n < 2; ++n) *(PG8_LAS f32x4*)(lds + row * SSM_ROWB + (wc * 32 + 8 * fq + 4 * n) * 4) = acc[ai][0][m][n]; }
        asm volatile("s_waitcnt lgkmcnt(0)" ::: "memory"); __builtin_amdgcn_s_barrier(); asm volatile("" ::: "memory");
        if (wid < 2) { const f32x2_t aT = AT[lane]; float cr = 0.f, ci = 0.f;
#pragma unroll 1
            for (int k0 = 0; k0 < 128; k0 += 8) { u32x2 sv[8];
#pragma unroll
                for (int i = 0; i < 8; ++i) sv[i] = *(const PG8_LAS u32x2*)(lds + (wid * 128 + k0 + i) * SSM_ROWB + lane * 8);
                asm volatile("s_waitcnt lgkmcnt(0)" ::: "memory");
#pragma unroll
                for (int i = 0; i < 8; ++i) { *(PG8_LAS unsigned*)(lds + (wid * 128 + k0 + i) * SSM_ROWB + lane * 4) = pk2(cr, ci);
                    const float sr = __uint_as_float(sv[i].x), si = __uint_as_float(sv[i].y), nr = aT.x * cr - aT.y * ci + sr, ni = aT.x * ci + aT.y * cr + si; cr = nr; ci = ni; }
                asm volatile("" ::: "memory"); } }
        asm volatile("s_waitcnt lgkmcnt(0)" ::: "memory"); __builtin_amdgcn_s_barrier(); asm volatile("" ::: "memory");
        const int tid = wid * 64 + lane;
#pragma unroll
        for (int i = 0; i < 8; ++i) { const int idx = tid + 512 * i, row = idx >> 4, ch = idx & 15;
            const u32x4 v = *(const PG8_LAS u32x4*)(lds + row * SSM_ROWB + ch * 16);
            *(u32x4*)(A2 + (size_t)(u.pm * BM + row) * 384 + 256 + ch * 8) = v; }
        asm volatile("s_waitcnt vmcnt(0) lgkmcnt(0)" ::: "memory"); __builtin_amdgcn_s_barrier(); asm volatile("" ::: "memory");
    }
};
__device__ __forceinline__ float gelu_tanh(float y) { const float z = 0.7978845608028654f * (y + 0.044715f * y * y * y); return y * fast_rcp(1.0f + fast_exp2(-2.0f * LOG2E * z)); }
struct EpiY {
    static constexpr bool PERM = true, AFTER_DRAIN = false; static constexpr int MID_T = -1; static constexpr int NST = 16;
    bf16_t* YG; int g;
    __device__ __forceinline__ void operator()(const f32x4 (&acc)[2][2][4][2], const Unit& u, int wr, int wc, int fr, int fq) const {
#pragma unroll
        for (int ai = 0; ai < 2; ++ai)
#pragma unroll
            for (int m = 0; m < 4; ++m) { const int R = u.pm * BM + ai * HALF + wr * 64 + m * 16 + fr;
#pragma unroll
                for (int bj = 0; bj < 2; ++bj) { const int idx = bj * HALF + wc * 32 + 8 * fq, tau = idx >> 4, c0 = idx & 15;
                    f32x4 y0, y1;
#pragma unroll
                    for (int i = 0; i < 4; ++i) { y0[i] = gelu_tanh(acc[ai][bj][m][0][i]); y1[i] = gelu_tanh(acc[ai][bj][m][1][i]); }
                    *(u32x4*)(YG + ((size_t)R * 16 + tau) * 512 + g * 16 + c0) = pack8(y0, y1); } }
    }
};
}

struct Args { const void* in[29]; float* out; unsigned char* ws; int ph_lo, ph_hi; };
enum { I_X = 0, I_P, I_POS, I_N1G, I_WIN, I_QG, I_KG, I_SINK, I_LRE, I_LIM, I_BRE, I_BIM, I_CRE, I_CIM, I_SD, I_LDT, I_GLUW, I_GLUB, I_AOG, I_SOG, I_WOUT, I_N2G,
       I_WG, I_WU, I_WD, I_PNG, I_WPG, I_BPG, I_WPP };

__device__ __forceinline__ void sincos_d(double x, double& s, double& c) {
    const double k = rint(x * 0.6366197723675814);
    double r = fma(-k, 1.5707963267341256, x); r = fma(-k, 6.077100506506192e-11, r);
    const double r2 = r * r;
    const double sp = r * (1.0 + r2 * (-1.0 / 6.0 + r2 * (1.0 / 120.0 + r2 * (-1.0 / 5040.0 + r2 * (1.0 / 362880.0 + r2 * (-1.0 / 39916800.0 + r2 * (1.0 / 6227020800.0)))))));
    const double cp = 1.0 + r2 * (-0.5 + r2 * (1.0 / 24.0 + r2 * (-1.0 / 720.0 + r2 * (1.0 / 40320.0 + r2 * (-1.0 / 3628800.0 + r2 * (1.0 / 479001600.0 + r2 * (-1.0 / 87178291200.0)))))));
    const int q = (int)k & 3;
    s = (q == 0) ? sp : (q == 1) ? cp : (q == 2) ? -sp : -cp;
    c = (q == 0) ? cp : (q == 1) ? -sp : (q == 2) ? -cp : sp;
}

__device__ __forceinline__ void tr_item(const float* __restrict__ W, int N, bf16* WT, int ldk, int kdst_off, const float* __restrict__ gain, int rowmul, int rowadd, int item, int lane, LAS float* scr) {
    const int nblk = N / 32, kb = item / nblk, nb = item % nblk, k0 = 64 * kb, n0 = 32 * nb;
    float w[32];
    const float* wp = W + (size_t)(k0 + (lane >> 5)) * N + n0 + (lane & 31);
#pragma unroll
    for (int i = 0; i < 32; ++i) w[i] = __builtin_nontemporal_load(wp + (size_t)(2 * i) * N);
    const int c = lane & 7;
    f32x4 g0 = {1.f, 1.f, 1.f, 1.f}, g1 = {1.f, 1.f, 1.f, 1.f};
    if (gain) { g0 = *(const f32x4*)(gain + k0 + 8 * c); g1 = *(const f32x4*)(gain + k0 + 8 * c + 4); }
#pragma unroll
    for (int i = 0; i < 32; ++i) scr[(2 * i + (lane >> 5)) * 33 + (lane & 31)] = w[i];
    LDS_WAIT(); asm volatile("" ::: "memory");
#pragma unroll
    for (int j = 0; j < 4; ++j) { const int n = (lane >> 3) + 8 * j; const LAS float* s = scr + (8 * c) * 33 + n;
        v4u o; o.x = pk2(s[0 * 33] * g0[0], s[1 * 33] * g0[1]); o.y = pk2(s[2 * 33] * g0[2], s[3 * 33] * g0[3]); o.z = pk2(s[4 * 33] * g1[0], s[5 * 33] * g1[1]); o.w = pk2(s[6 * 33] * g1[2], s[7 * 33] * g1[3]);
        const int nn = n0 + n, drow = (nn >> 7) * rowmul + (nn & 127) + rowadd;
        *(v4u*)(WT + (size_t)drow * ldk + kdst_off + k0 + 8 * c) = o; }
    LDS_WAIT(); asm volatile("" ::: "memory");
}

__device__ __forceinline__ void ssm_tables(LAS unsigned char* lds, int g, int part, const Args& a, bf16* GT, bf16* ET, f32x2_t* AT) {
    const int tid = threadIdx.x;
    LAS f32x2_t* P = (LAS f32x2_t*)lds;
    LAS f32x2_t* Bb = P + 64 * 17;
    LAS f32x2_t* Cc = Bb + 64 * 16;
    LAS float* Kt = (LAS float*)(Cc + 16 * 64);
    const float* lre = (const float*)a.in[I_LRE] + g * 64; const float* lim = (const float*)a.in[I_LIM] + g * 64;
    const float* bre = (const float*)a.in[I_BRE] + g * 1024; const float* bim = (const float*)a.in[I_BIM] + g * 1024;
    const float* cre = (const float*)a.in[I_CRE] + g * 1024; const float* cim = (const float*)a.in[I_CIM] + g * 1024;
    const float* dsk = (const float*)a.in[I_SD] + g * 16;
    const double dt = exp((double)((const float*)a.in[I_LDT])[g]);
    for (int t = tid; t < 64 * 17; t += NTHR) { const int n = t / 17, d = t % 17;
        const double lr = fmin((double)lre[n], -1e-4), li = (double)lim[n];
        const double mag = exp(lr * dt * (double)d), ang = li * dt * (double)d; double sn, cs; sincos_d(ang, sn, cs);
        P[t] = (f32x2_t){(float)(mag * cs), (float)(mag * sn)}; }
    for (int t = tid; t < 1024; t += NTHR) { const int n = t / 16;
        const double lr = fmin((double)lre[n], -1e-4), li = (double)lim[n];
        const double mag = exp(lr * dt), ang = li * dt; double sn, cs; sincos_d(ang, sn, cs);
        const double nr = mag * cs - 1.0, ni = mag * sn, den = lr * lr + li * li;
        const double fr = (nr * lr + ni * li) / den, fi = (ni * lr - nr * li) / den, br = (double)bre[t], bi = (double)bim[t];
        Bb[t] = (f32x2_t){(float)(fr * br - fi * bi), (float)(fr * bi + fi * br)};
        Cc[t] = (f32x2_t){cre[t], cim[t]}; }
    __syncthreads();
    {
      const int lane = tid & 63, wv = tid >> 6, cl = lane & 15, kq = lane >> 4;
#pragma unroll
      for (int dd = 0; dd < 2; ++dd) { const int d = 2 * wv + dd; f32x4 kacc = {0.f, 0.f, 0.f, 0.f};
#pragma unroll 4
          for (int st = 0; st < 32; ++st) { const int k = 4 * st + kq, n = k >> 1, ri = k & 1;
              const f32x2_t cc = Cc[cl * 64 + n], pp = P[n * 17 + d], bb = Bb[n * 16 + cl];
              const float av = ri ? -(cc.x * pp.y + cc.y * pp.x) : (cc.x * pp.x - cc.y * pp.y), bv = ri ? bb.y : bb.x;
              kacc = __builtin_amdgcn_mfma_f32_16x16x4f32(av, bv, kacc, 0, 0, 0); }
#pragma unroll
          for (int r = 0; r < 4; ++r) { const int c = 4 * kq + r; float v = kacc[r]; if (d == 0 && c == cl) v += dsk[c]; Kt[d * 256 + c * 16 + cl] = v; } } }
    __syncthreads();
    bf16* Gg = GT + (size_t)g * 256 * 384; bf16* Eg = ET + (size_t)g * 32768; bf16* Fg = Gg + 256;
    for (int q = tid; q < 1024; q += NTHR) { const int row = q >> 5, tau = 2 * part + (row >> 4), c = row & 15, col0 = (q & 31) * 8, j = col0 >> 4, c0 = col0 & 15;
        float v[8];
#pragma unroll
        for (int i = 0; i < 8; ++i) v[i] = (j <= tau) ? Kt[((tau - j) & 15) * 256 + c * 16 + c0 + i] : 0.f;
        v4u o; o.x = pk2(v[0], v[1]); o.y = pk2(v[2], v[3]); o.z = pk2(v[4], v[5]); o.w = pk2(v[6], v[7]);
        *(v4u*)(Gg + (size_t)(tau * 16 + c) * 384 + col0) = o; }
    { const int row = tid >> 5, np = 16 * part + row, n = np >> 1, ri = np & 1, col0 = (tid & 31) * 8, j = col0 >> 4, c0 = col0 & 15;
        const f32x2_t pp = P[n * 17 + (15 - j)]; float v[8];
#pragma unroll
        for (int i = 0; i < 8; ++i) { const f32x2_t bb = Bb[n * 16 + c0 + i]; v[i] = ri ? (pp.x * bb.y + pp.y * bb.x) : (pp.x * bb.x - pp.y * bb.y); }
        v4u o; o.x = pk2(v[0], v[1]); o.y = pk2(v[2], v[3]); o.z = pk2(v[4], v[5]); o.w = pk2(v[6], v[7]);
        *(v4u*)(Eg + (size_t)np * 256 + col0) = o; }
    { const int row = tid >> 4, tau = 2 * part + (row >> 4), c = row & 15, col0 = (tid & 15) * 8; float v[8];
#pragma unroll
        for (int i = 0; i < 8; ++i) { const int n = (col0 + i) >> 1, ri = (col0 + i) & 1; const f32x2_t cc = Cc[c * 64 + n], pp = P[n * 17 + tau + 1];
            v[i] = ri ? -(cc.x * pp.y + cc.y * pp.x) : (cc.x * pp.x - cc.y * pp.y); }
        v4u o; o.x = pk2(v[0], v[1]); o.y = pk2(v[2], v[3]); o.z = pk2(v[4], v[5]); o.w = pk2(v[6], v[7]);
        *(v4u*)(Fg + (size_t)(tau * 16 + c) * 384 + col0) = o; }
    if (part == 0 && tid < 64) AT[g * 64 + tid] = P[tid * 17 + 16];
    __syncthreads();
}

__device__ __forceinline__ void p0_prologue(LAS unsigned char* lds, const Args& a, int vcu, int G) {
    const int tid = threadIdx.x, lane = tid & 63, wave = __builtin_amdgcn_readfirstlane(tid >> 6);
    unsigned char* ws = a.ws;
    LAS float* scr = (LAS float*)(lds + wave * 16384);
    const int gw = vcu * NWAVES + wave, NGW = G * NWAVES;
    const int tpos = vcu & 3;
#pragma unroll
    for (int sx = 0; sx < 4; ++sx) {
        const int st = sx < tpos ? sx : sx - 1;
        if (sx == tpos) { __syncthreads();
            for (int u = vcu; u < NG * 8; u += G) ssm_tables(lds, u >> 3, u & 7, a, (bf16*)(ws + WS_SSMG), (bf16*)(ws + WS_SSME), (f32x2_t*)(ws + WS_AT));
            continue; }
        const int task = (wave < 4) ? st : (st + 1) % 3;
        if (task == 0) {
            constexpr int I_IN = 16 * 40, I_GL = 8 * 16, I_OA = 8 * 32, I_OS = 8 * 32, I_G = 16 * 88, I_U = 16 * 88, I_D = 44 * 32, I_PG_ = 16 * 32, I_PP_ = 4 * 32;
            constexpr int NITEMS = I_IN + I_GL + I_OA + I_OS + I_G + I_U + I_D + I_PG_ + I_PP_;
            for (int it = gw; it < NITEMS; it += NGW) {
                int r = it;
                if (r < I_IN) { tr_item((const float*)a.in[I_WIN], INW, (bf16*)(ws + WS_WIN), 1024, 0, (const float*)a.in[I_N1G], 128, 0, r, lane, scr); continue; } r -= I_IN;
                if (r < I_GL) { tr_item((const float*)a.in[I_GLUW], 512, (bf16*)(ws + WS_GLU), 512, 0, nullptr, 128, 0, r, lane, scr); continue; } r -= I_GL;
                if (r < I_OA) { tr_item((const float*)a.in[I_WOUT], 1024, (bf16*)(ws + WS_WOUT), 1024, 512, (const float*)a.in[I_AOG], 128, 0, r, lane, scr); continue; } r -= I_OA;
                if (r < I_OS) { tr_item((const float*)a.in[I_WOUT] + 512 * 1024, 1024, (bf16*)(ws + WS_WOUT), 1024, 0, (const float*)a.in[I_SOG], 128, 0, r, lane, scr); continue; } r -= I_OS;
                if (r < I_G) { tr_item((const float*)a.in[I_WG], DFF, (bf16*)(ws + WS_WUP), 1024, 0, (const float*)a.in[I_N2G], 256, 0, r, lane, scr); continue; } r -= I_G;
                if (r < I_U) { tr_item((const float*)a.in[I_WU], DFF, (bf16*)(ws + WS_WUP), 1024, 0, (const float*)a.in[I_N2G], 256, 128, r, lane, scr); continue; } r -= I_U;
                if (r < I_D) { tr_item((const float*)a.in[I_WD], 1024, (bf16*)(ws + WS_WDN), DFF, 0, nullptr, 128, 0, r, lane, scr); continue; } r -= I_D;
                if (r < I_PG_) { tr_item((const float*)a.in[I_WPG], 1024, (bf16*)(ws + WS_WPG), 1024, 0, (const float*)a.in[I_PNG], 128, 0, r, lane, scr); continue; } r -= I_PG_;
                tr_item((const float*)a.in[I_WPP], 1024, (bf16*)(ws + WS_WPP), 256, 0, nullptr, 128, 0, r, lane, scr);
            }
        } else if (task == 1) {
            const float* x = (const float*)a.in[I_X]; bf16* XB = (bf16*)(ws + WS_R); float* RS1 = (float*)(ws + WS_RS1);
            const int nst = (M / 2 - gw + NGW - 1) / NGW;
            f32x4 va[2][4], vb[2][4];
#pragma unroll
            for (int r = 0; r < 2; ++r) { const f32x4* xr = (const f32x4*)(x + (size_t)(gw * 2 + r) * DM) + lane;
#pragma unroll
                for (int j = 0; j < 4; ++j) va[r][j] = __builtin_nontemporal_load(xr + 64 * j); }
#define XB_STEP(CUR, NXT, it) do { const int m0 = (gw + (it) * NGW) * 2; \
                if ((it) + 1 < nst) { _Pragma("unroll") for (int r = 0; r < 2; ++r) { const f32x4* xr = (const f32x4*)(x + (size_t)(m0 + NGW * 2 + r) * DM) + lane; \
                    _Pragma("unroll") for (int j = 0; j < 4; ++j) NXT[r][j] = __builtin_nontemporal_load(xr + 64 * j); } } \
                _Pragma("unroll") for (int r = 0; r < 2; ++r) { float s2 = 0.f; \
                    _Pragma("unroll") for (int j = 0; j < 4; ++j) { const f32x4 t = CUR[r][j]; s2 += (t.x * t.x + t.y * t.y) + (t.z * t.z + t.w * t.w); } \
                    s2 = wave_sum(s2); \
                    if (lane == 0) RS1[m0 + r] = rsqrtf(s2 * (1.f / DM) + EPS); \
                    unsigned long long* o8 = (unsigned long long*)(XB + (size_t)(m0 + r) * DM) + lane; \
                    _Pragma("unroll") for (int j = 0; j < 4; ++j) { const f32x4 t = CUR[r][j]; o8[64 * j] = (unsigned long long)pk2(t.x, t.y) | ((unsigned long long)pk2(t.z, t.w) << 32); } } } while (0)
#pragma unroll 1
            for (int i2 = 0; i2 < nst; i2 += 2) { XB_STEP(va, vb, i2); if (i2 + 1 < nst) XB_STEP(vb, va, i2 + 1); }
#undef XB_STEP
        } else {
            const int gt = gw * 64 + lane, NGT = NGW * 64;
            const f32x4* p4 = (const f32x4*)a.in[I_P]; v4u* pb = (v4u*)(ws + WS_D);
            for (int i0 = gt; i0 < M * PLED / 8; i0 += NGT * 4) { f32x4 v0[4], v1[4];
#pragma unroll
                for (int q = 0; q < 4; ++q) { const int i = i0 + q * NGT; if (i < M * PLED / 8) { v0[q] = __builtin_nontemporal_load(p4 + 2 * i); v1[q] = __builtin_nontemporal_load(p4 + 2 * i + 1); } }
#pragma unroll
                for (int q = 0; q < 4; ++q) { const int i = i0 + q * NGT; if (i < M * PLED / 8) { v4u o; o.x = pk2(v0[q].x, v0[q].y); o.y = pk2(v0[q].z, v0[q].w); o.z = pk2(v1[q].x, v1[q].y); o.w = pk2(v1[q].z, v1[q].w); pb[i] = o; } } }
            const int* pos = (const int*)a.in[I_POS]; float* rope = (float*)(ws + WS_ROPE);
            for (int i = gt; i < M * 8; i += NGT) { const int tok = i >> 3, k = i & 7;
                const double inv = (k == 0) ? 1.0 : (k == 1) ? 0.19392274474868576 : (k == 2) ? 0.03760603093086393 : (k == 3) ? 0.007292664737217109 : (k == 4) ? 0.001414213562373095
                                 : (k == 5) ? 0.0002742481756762073 : (k == 6) ? 5.318295896944988e-05 : 1.031338537721246e-05;
                double sn, cs; sincos_d((double)pos[tok] * inv, sn, cs); rope[tok * 16 + k] = (float)cs; rope[tok * 16 + 8 + k] = (float)sn; }
        }
    }
}

constexpr int ATT_KSTR = 144, ATT_VSTR = 160;
constexpr int ATT_KN = 0, ATT_V = 2 * 192 * ATT_KSTR, ATT_SSQ = ATT_V + 2 * 192 * ATT_VSTR, ATT_END = ATT_SSQ + 8 * 64 * 4;
static_assert(ATT_END <= RING_BYTES, "attention LDS");
typedef short v4i16_t __attribute__((ext_vector_type(4)));
__device__ __forceinline__ u32x2 lds_tr16(const LAS unsigned char* p) { return __builtin_bit_cast(u32x2, __builtin_amdgcn_ds_read_tr16_b64_v4i16((LAS v4i16_t*)p)); }
__device__ __forceinline__ void unpack8(const v4u& w, float (&v)[8]) { v[0] = bf2f_lo(w.x); v[1] = bf2f_hi(w.x); v[2] = bf2f_lo(w.y); v[3] = bf2f_hi(w.y); v[4] = bf2f_lo(w.z); v[5] = bf2f_hi(w.z); v[6] = bf2f_lo(w.w); v[7] = bf2f_hi(w.w); }
__device__ __forceinline__ v4u pack8f(const float (&v)[8]) { v4u w; w.x = pk2(v[0], v[1]); w.y = pk2(v[2], v[3]); w.z = pk2(v[4], v[5]); w.w = pk2(v[6], v[7]); return w; }
__device__ __forceinline__ float max3f(float a, float b, float c) { float r; asm("v_max3_f32 %0, %1, %2, %3" : "=v"(r) : "v"(a), "v"(b), "v"(c)); return r; }
__device__ __forceinline__ void attn_unit(LAS unsigned char* lds, int b, int c, bool first, const bf16* __restrict__ Q, const bf16* __restrict__ Kb, const bf16* __restrict__ Vb, const float* __restrict__ rope,
                                          const float* __restrict__ gq, const float* __restrict__ gk, const float* __restrict__ sinks, bf16* MIX, float* SSQA) {
    const int tid = threadIdx.x, lane = tid & 63, wid = __builtin_amdgcn_readfirstlane(tid >> 6);
    const int hq = wid, kvh = wid >> 2, fr = lane & 15, quad = lane >> 4;
    v4u qraw[4][2];
#pragma unroll
    for (int qt = 0; qt < 4; ++qt) { const bf16* qp = Q + ((size_t)b * SEQ + c * 64 + qt * 16 + fr) * 512 + hq * 64 + quad * 8; qraw[qt][0] = __builtin_nontemporal_load((const v4u*)qp); qraw[qt][1] = __builtin_nontemporal_load((const v4u*)(qp + 32)); }
    { const int sub = tid & 7;
      f32x4 gk0 = *(const f32x4*)(gk + sub * 8), gk1 = *(const f32x4*)(gk + sub * 8 + 4);
      const int nch = first ? 3 : 1, ngrp = first ? 2 : 1, gsz = first ? 3 : 2;
#pragma unroll 1
      for (int grp = 0; grp < ngrp; ++grp) {
          v4u kr[3], vr[3]; f32x4 cs[3][4]; int lrow[3];
#pragma unroll
          for (int i = 0; i < 3; ++i) { const int p = (grp * gsz + i) * 64 + (tid >> 3), kvh2 = p / (64 * nch), r = p % (64 * nch), x = (first ? c - 2 + (r >> 6) : c), slot = (x + 3) % 3;
              const long tok = (long)b * SEQ + x * 64 + (r & 63);
              lrow[i] = kvh2 * 192 + slot * 64 + (r & 63);
              kr[i] = (v4u){0u, 0u, 0u, 0u}; vr[i] = (v4u){0u, 0u, 0u, 0u};
#pragma unroll
              for (int j = 0; j < 4; ++j) cs[i][j] = (f32x4){0.f, 0.f, 0.f, 0.f};
              if (i < gsz && x >= 0) { kr[i] = *(const v4u*)(Kb + tok * 128 + kvh2 * 64 + sub * 8); vr[i] = *(const v4u*)(Vb + tok * 128 + kvh2 * 64 + sub * 8);
                  if (sub < 2) {
#pragma unroll
                      for (int j = 0; j < 4; ++j) cs[i][j] = *(const f32x4*)(rope + tok * 16 + 4 * j); } } }
#pragma unroll
          for (int i = 0; i < 3; ++i) { if (i < gsz) {
              float v[8]; unpack8(kr[i], v);
              float ss = 0.f;
#pragma unroll
              for (int e = 0; e < 8; ++e) ss += v[e] * v[e];
              ss += __shfl_xor(ss, 1); ss += __shfl_xor(ss, 2); ss += __shfl_xor(ss, 4);
              const float rs = rsqrtf(ss * (1.f / 64.f) + EPS);
              float o[8];
#pragma unroll
              for (int e = 0; e < 8; ++e) { v[e] *= rs * (e < 4 ? gk0[e] : gk1[e - 4]); o[e] = __shfl_xor(v[e], 1); }
              if (sub < 2) {
#pragma unroll
                  for (int e = 0; e < 8; ++e) { const float cv = cs[i][e >> 2][e & 3], sv = cs[i][2 + (e >> 2)][e & 3]; v[e] = (sub == 0) ? (v[e] * cv - o[e] * sv) : (o[e] * sv + v[e] * cv); } }
              *(LAS v4u*)(lds + ATT_KN + lrow[i] * ATT_KSTR + sub * 16) = pack8f(v);
              *(LAS v4u*)(lds + ATT_V + lrow[i] * ATT_VSTR + sub * 16) = vr[i]; } } } }
    bf16x8 qf[4][2];
    { f32x4 cs[4][4];
#pragma unroll
      for (int qt = 0; qt < 4; ++qt)
#pragma unroll
          for (int j = 0; j < 4; ++j) cs[qt][j] = (quad < 2) ? *(const f32x4*)(rope + ((size_t)b * SEQ + c * 64 + qt * 16 + fr) * 16 + 4 * j) : (f32x4){0.f, 0.f, 0.f, 0.f};
      const f32x4 g00 = *(const f32x4*)(gq + quad * 8), g01 = *(const f32x4*)(gq + quad * 8 + 4), g10 = *(const f32x4*)(gq + 32 + quad * 8), g11 = *(const f32x4*)(gq + 32 + quad * 8 + 4);
#pragma unroll
      for (int qt = 0; qt < 4; ++qt) { float v0[8], v1[8]; unpack8(qraw[qt][0], v0); unpack8(qraw[qt][1], v1);
          float ss = 0.f;
#pragma unroll
          for (int e = 0; e < 8; ++e) ss += v0[e] * v0[e] + v1[e] * v1[e];
          ss += __shfl_xor(ss, 16); ss += __shfl_xor(ss, 32);
          const float rs = rsqrtf(ss * (1.f / 64.f) + EPS) * QSCALE;
          float o[8];
#pragma unroll
          for (int e = 0; e < 8; ++e) { v0[e] *= rs * (e < 4 ? g00[e] : g01[e - 4]); v1[e] *= rs * (e < 4 ? g10[e] : g11[e - 4]); o[e] = __shfl_xor(v0[e], 16); }
          if (quad < 2) {
#pragma unroll
              for (int e = 0; e < 8; ++e) { const float cv = cs[qt][e >> 2][e & 3], sv = cs[qt][2 + (e >> 2)][e & 3]; v0[e] = (quad == 0) ? (v0[e] * cv - o[e] * sv) : (o[e] * sv + v0[e] * cv); } }
          qf[qt][0] = __builtin_bit_cast(bf16x8, pack8f(v0)); qf[qt][1] = __builtin_bit_cast(bf16x8, pack8f(v1)); } }
    __syncthreads();
    const float sink2 = sinks[hq] * LOG2E;
    bool sv[3];
#pragma unroll
    for (int sl = 0; sl < 3; ++sl) sv[sl] = (c - ((c - sl) % 3 + 3) % 3) >= 0;
    f32x4 O[4][4];
    const LAS unsigned char* kbase = lds + ATT_KN + (kvh * 192 + fr) * ATT_KSTR + quad * 16;
    const LAS unsigned char* vbase = lds + ATT_V + (kvh * 192 + 4 * quad + (fr >> 2)) * ATT_VSTR + (fr & 3) * 8;
#pragma unroll
    for (int qt = 0; qt < 4; ++qt) {
        f32x4 S[12];
#pragma unroll
        for (int kt = 0; kt < 12; ++kt) {
            const bf16x8 a0 = *(const LAS bf16x8*)(kbase + kt * 16 * ATT_KSTR), a1 = *(const LAS bf16x8*)(kbase + kt * 16 * ATT_KSTR + 64);
            f32x4 sacc = {0.f, 0.f, 0.f, 0.f}; sacc = MFMA16(a0, qf[qt][0], sacc); sacc = MFMA16(a1, qf[qt][1], sacc); S[kt] = sacc; }
        float mx = -1e30f;
#pragma unroll
        for (int kt = 0; kt < 12; ++kt) if (sv[kt >> 2]) mx = max3f(mx, max3f(S[kt][0], S[kt][1], S[kt][2]), S[kt][3]);
        mx = max3f(mx, __shfl_xor(mx, 16), sink2); mx = fmaxf(mx, __shfl_xor(mx, 32));
        float sum = 0.f;
#pragma unroll
        for (int kt = 0; kt < 12; ++kt)
#pragma unroll
            for (int r = 0; r < 4; ++r) { const float pz = sv[kt >> 2] ? fast_exp2(S[kt][r] - mx) : 0.f; S[kt][r] = pz; sum += pz; }
        sum += __shfl_xor(sum, 16); sum += __shfl_xor(sum, 32);
        const float inv = 1.0f / (sum + fast_exp2(sink2 - mx));
#pragma unroll
        for (int dt = 0; dt < 4; ++dt) O[qt][dt] = (f32x4){0.f, 0.f, 0.f, 0.f};
#pragma unroll
        for (int s6 = 0; s6 < 6; ++s6) {
            v4u pw; pw.x = pk2(S[2 * s6][0], S[2 * s6][1]); pw.y = pk2(S[2 * s6][2], S[2 * s6][3]); pw.z = pk2(S[2 * s6 + 1][0], S[2 * s6 + 1][1]); pw.w = pk2(S[2 * s6 + 1][2], S[2 * s6 + 1][3]);
            const bf16x8 pb = __builtin_bit_cast(bf16x8, pw);
#pragma unroll
            for (int dt = 0; dt < 4; ++dt) {
                const u32x2 lo = lds_tr16(vbase + (s6 * 32) * ATT_VSTR + dt * 32), hi = lds_tr16(vbase + (s6 * 32 + 16) * ATT_VSTR + dt * 32);
                v4u aw; aw.x = lo.x; aw.y = lo.y; aw.z = hi.x; aw.w = hi.y;
                O[qt][dt] = MFMA16(__builtin_bit_cast(bf16x8, aw), pb, O[qt][dt]); } }
        float s2 = 0.f;
#pragma unroll
        for (int dt = 0; dt < 4; ++dt) { O[qt][dt] *= inv; s2 += (O[qt][dt][0] * O[qt][dt][0] + O[qt][dt][1] * O[qt][dt][1]) + (O[qt][dt][2] * O[qt][dt][2] + O[qt][dt][3] * O[qt][dt][3]); }
        s2 += __shfl_xor(s2, 16); s2 += __shfl_xor(s2, 32);
        const size_t row = (size_t)b * SEQ + c * 64 + qt * 16 + fr;
        if (quad == 0) SSQA[row * 8 + hq] = s2;
        bf16* dst = MIX + row * 1024 + 512 + hq * 64 + 4 * quad;
#pragma unroll
        for (int dt = 0; dt < 4; ++dt) { u32x2 w; w.x = pk2(O[qt][dt][0], O[qt][dt][1]); w.y = pk2(O[qt][dt][2], O[qt][dt][3]); *(u32x2*)(dst + dt * 16) = w; }
        __builtin_amdgcn_sched_barrier(0);
    }
    __syncthreads();
}

static_assert(256 * pg8::SSM_ROWB <= MISC_OFF, "SSM LDS");
__device__ __forceinline__ void ssm_unit(LAS unsigned char* lds, int g, int rt, unsigned char* ws) {
    pg8::bf16_t* A2 = (pg8::bf16_t*)(ws + WS_U) + (size_t)g * 2048 * 384;
    pg8::OneUnit S{rt};
    { pg8::Gemm g1{A2, (const pg8::bf16_t*)(ws + WS_SSME) + (size_t)g * 32768, 2048, 256, 256, 384};
      pg8::EpiSend E{(const f32x2_t*)(ws + WS_AT) + g * 64, A2};
      pg8::gemm_phase<pg8::EpiSend, pg8::OneUnit, false, true>(lds, g1, S, E); }
    { pg8::Gemm g2{A2, (const pg8::bf16_t*)(ws + WS_SSMG) + (size_t)g * 256 * 384, 2048, 256, 384, 384};
      pg8::EpiY E{(pg8::bf16_t*)(ws + WS_D), g};
      pg8::gemm_phase<pg8::EpiY, pg8::OneUnit, false, true>(lds, g2, S, E); }
}

__device__ __forceinline__ void panel_publish(unsigned* cnt) {
    asm volatile("s_waitcnt vmcnt(0)" ::: "memory");
    __syncthreads();
    if (threadIdx.x == 0) { __builtin_amdgcn_fence(__ATOMIC_RELEASE, "agent"); asm volatile("s_waitcnt vmcnt(0)" ::: "memory");
        __hip_atomic_fetch_add(cnt, 1u, __ATOMIC_RELAXED, __HIP_MEMORY_SCOPE_AGENT); }
}
__device__ __forceinline__ void panel_wait(unsigned* cnt, unsigned need, unsigned* tmo) {
    if (threadIdx.x < 64) { const unsigned long long t0 = __builtin_amdgcn_s_memrealtime();
        while ((unsigned)__builtin_amdgcn_readfirstlane(__hip_atomic_load(cnt, __ATOMIC_RELAXED, __HIP_MEMORY_SCOPE_AGENT)) < need) {
            if (__builtin_amdgcn_s_memrealtime() - t0 > 2000000ull) { if (threadIdx.x == 0) __hip_atomic_store(tmo, 1u, __ATOMIC_RELAXED, __HIP_MEMORY_SCOPE_AGENT); break; }
            __builtin_amdgcn_s_sleep(2); }
        __builtin_amdgcn_fence(__ATOMIC_ACQUIRE, "agent");
        asm volatile("s_waitcnt vmcnt(0)" ::: "memory"); }
    __syncthreads();
}
namespace pg8 {
struct TileUnit { int pm, pn;
    __device__ __forceinline__ bool next(int i, Unit& u) const { if (i) return false; u.pm = pm; u.pn = pn; return true; }
    __device__ __forceinline__ void a_ready(const Unit&) const {}
    __device__ __forceinline__ void done(const Unit&) const {} };
struct ListOrder : StaticOrder { int base, cnt;
    __device__ __forceinline__ bool next(int i, Unit& u) const { if (i >= cnt) return false; StaticOrder t = *this; t.c = base + i; t.G = nwg; return t.StaticOrder::next(0, u); } };
}

__global__ void __launch_bounds__(NTHR, 2) hymba_fwd(Args args) {
    extern __shared__ __attribute__((aligned(16))) unsigned char lds_raw[];
    LAS unsigned char* lds = (LAS unsigned char*)lds_raw;
    const int tid = threadIdx.x;
    const int G = gridDim.x, bx = blockIdx.x;
    const int vcu = (G % 8 == 0) ? (bx % 8) * (G / 8) + bx / 8 : bx;
    unsigned char* ws = args.ws;
    const int lo = args.ph_lo, hi = args.ph_hi;
#if MK_N_LAUNCHES == 1
#if MK_BARRIER == 1
    volatile LAS unsigned* MISC = (volatile LAS unsigned*)(lds + MISC_OFF);
    if (tid < 32) MISC[tid] = 0u;
    __syncthreads();
    XcdBarrier bar = xcd_barrier_post((unsigned*)(ws + WS_CTL) + CW_BAR, MISC + 8);
#define GRID_BAR() xcd_barrier(bar)
#else
    cg::grid_group grid = cg::this_grid();
#define GRID_BAR() grid.sync()
#endif
#else
#define GRID_BAR() do {} while (0)
#endif
#ifndef PHASE_MASK
#define PHASE_MASK 0xff
#endif
#define IN(k) ((((PHASE_MASK) >> (k)) & 1) && lo <= (k) && (k) < hi)
#define SEAM(k) do { if (IN(k) && IN((k) + 1)) GRID_BAR(); } while (0)
#if MK_N_LAUNCHES == 1 && MK_BARRIER == 1 && !defined(NO_LOCAL_SEAMS)
#define SEAM_LOCAL(k) do { if (IN(k) && IN((k) + 1)) xcd_barrier(bar, uni); } while (0)
#else
#define SEAM_LOCAL(k) SEAM(k)
#endif
#ifndef REPEAT_PHASE
#define REPEAT_PHASE -1
#endif
#ifndef MERGE67
#define MERGE67 0
#endif
#define REP(k) for (int rep_ = 0; rep_ < ((REPEAT_PHASE == (k)) ? 2 : 1); ++rep_)
#define REPBAR() do { if (rep_) GRID_BAR(); } while (0)

    if (IN(0)) REP(0) { REPBAR(); p0_prologue(lds, args, vcu, G); }
    SEAM(0);
    int wid = bx, vwid = vcu; bool uni = false;
#if MK_N_LAUNCHES == 1 && MK_BARRIER == 1 && !defined(NO_LOCAL_SEAMS)
    if (IN(0) && IN(1)) { uni = __builtin_amdgcn_readfirstlane((int)MISC[10]) != 0;
        if (uni) { const int rank = __builtin_amdgcn_readfirstlane((int)MISC[11]); wid = rank * 8 + (int)bar.x; vwid = (int)bar.x * (G / 8) + rank; } }
#endif
    if (IN(1)) REP(1) { REPBAR();
#ifndef NO_Z
        { pg8::Gemm g{(const pg8::bf16_t*)(ws + WS_R), (const pg8::bf16_t*)(ws + WS_WIN), M, INW, DM}; pg8::StaticOrder S; S.init(M, INW, G, wid);
          pg8::EpiZ E{(pg8::bf16_t*)(ws + WS_Q), (pg8::bf16_t*)(ws + WS_K), (pg8::bf16_t*)(ws + WS_V), (pg8::bf16_t*)(ws + WS_U), (const float*)(ws + WS_RS1)};
          pg8::gemm_phase<pg8::EpiZ, pg8::StaticOrder, true, true>(lds, g, S, E); }
#endif
#ifndef NO_PP
        { pg8::Gemm g{(const pg8::bf16_t*)(ws + WS_D), (const pg8::bf16_t*)(ws + WS_WPP), M, DM, PLED}; pg8::StaticOrder S;
          pg8::EpiB16 E{(pg8::bf16_t*)(ws + WS_B), DM};
          if (G == 256) { pg8::ListOrder L; L.init(M, DM, 1, 0);
              if (wid < 128) { L.base = wid; L.cnt = 1; } else { L.base = 128 + (wid - 128) * 3; L.cnt = 3; }
              pg8::gemm_phase<pg8::EpiB16, pg8::ListOrder, true, true>(lds, g, L, E); }
          else { S.init(M, DM, G, wid); pg8::gemm_phase<pg8::EpiB16, pg8::StaticOrder, true, true>(lds, g, S, E); } }
#endif
    }
    SEAM(1);
#if MK_N_LAUNCHES == 1 && MK_BARRIER == 1 && !defined(NO_SPLIT2)
    const bool split2 = IN(2) && IN(3) && IN(4) && IN(5);
#else
    const bool split2 = false;
#endif
    if (IN(2)) {
        for (int u = vwid; u < NG * 8; u += G)
            ssm_unit(lds, u >> 3, u & 7, ws);
#if MK_N_LAUNCHES == 1 && MK_BARRIER == 1
        if (split2) xcd_barrier_arrive(bar);
#endif
        for (int u = vwid * 2; u < BATCH * 32; u += G * 2)
            for (int i = 0; i < 2; ++i) { const int uu = u + i;
                attn_unit(lds, uu >> 5, uu & 31, i == 0, (const bf16*)(ws + WS_Q), (const bf16*)(ws + WS_K), (const bf16*)(ws + WS_V), (const float*)(ws + WS_ROPE),
                          (const float*)args.in[I_QG], (const float*)args.in[I_KG], (const float*)args.in[I_SINK], (bf16*)(ws + WS_A), (float*)(ws + WS_SSQA)); }
    }
#if MK_N_LAUNCHES == 1 && MK_BARRIER == 1
    if (split2) { xcd_barrier_wait_global(bar, 2u); flat_arrive((unsigned*)(ws + WS_CTL) + CW_ATT); }
    else
#endif
    SEAM(2);
    if (IN(3)) REP(3) { REPBAR();
        pg8::Gemm g{(const pg8::bf16_t*)(ws + WS_D), (const pg8::bf16_t*)(ws + WS_GLU), M, SW, SW}; pg8::StaticOrder S; S.init(M, SW, G, wid);
        pg8::EpiGlu E{(const pg8::bf16_t*)(ws + WS_D), (const float*)args.in[I_GLUB], (pg8::bf16_t*)(ws + WS_A), (float*)(ws + WS_SSQS)};
        pg8::gemm_phase<pg8::EpiGlu, pg8::StaticOrder, true, true>(lds, g, S, E);
    }
    SEAM_LOCAL(3);
    if (IN(4)) REP(4) { REPBAR();
        pg8::Gemm g{(const pg8::bf16_t*)(ws + WS_A), (const pg8::bf16_t*)(ws + WS_WOUT), M, DM, DM}; pg8::StaticOrder S; S.init(M, DM, G, wid);
        pg8::EpiH1 E{(const pg8::bf16_t*)(ws + WS_R), (pg8::bf16_t*)(ws + WS_R), (const float*)(ws + WS_SSQS), (float*)(ws + WS_SSQ1), (const float*)(ws + WS_SSQA)};
        pg8::gemm_phase<pg8::EpiH1, pg8::StaticOrder, true, true>(lds, g, S, E);
    }
    SEAM_LOCAL(4);
#if MK_N_LAUNCHES == 1 && MK_BARRIER == 1
    if (split2) flat_wait((unsigned*)(ws + WS_CTL) + CW_ATT, (unsigned)G, (unsigned*)(ws + WS_CTL) + CW_BAR);
#endif
    if (IN(5)) REP(5) { REPBAR();
        pg8::Gemm g{(const pg8::bf16_t*)(ws + WS_R), (const pg8::bf16_t*)(ws + WS_WUP), M, 2 * DFF, DM}; pg8::StaticOrder S; S.init(M, 2 * DFF, G, wid);
        pg8::EpiSwiGlu E{(const float*)(ws + WS_SSQ1), (pg8::bf16_t*)(ws + WS_ACT), -1, 0.f, 0.f};
        pg8::gemm_phase<pg8::EpiSwiGlu, pg8::StaticOrder, true, true>(lds, g, S, E);
    }
    SEAM_LOCAL(5);
    if (MERGE67 && IN(6) && IN(7) && G == 256 && (REPEAT_PHASE != 6) && (REPEAT_PHASE != 7)) {
        unsigned* ctl = (unsigned*)(ws + WS_CTL);
        pg8::StaticOrder S; S.init(M, DM, G, wid);
        pg8::Unit un0, un1; S.next(0, un0); S.next(1, un1);
        const int odd = wid & 1;
#pragma unroll 1
        for (int st = 0; st < 4; ++st) {
            const int kind = odd ? (st & 1) : (st >> 1), ui = odd ? (st >> 1) : (st & 1);
            const pg8::TileUnit T{ui ? un1.pm : un0.pm, ui ? un1.pn : un0.pn};
            if (kind == 0) {
                pg8::Gemm g{(const pg8::bf16_t*)(ws + WS_ACT), (const pg8::bf16_t*)(ws + WS_WDN), M, DM, DFF};
                pg8::EpiH2 E{(const pg8::bf16_t*)(ws + WS_R), (pg8::bf16_t*)(ws + WS_R), (float*)(ws + WS_SSQ2)};
                pg8::gemm_phase<pg8::EpiH2, pg8::TileUnit, false, true>(lds, g, T, E);
                panel_publish(ctl + CW_CNT6 + 64 * T.pm);
            } else {
                panel_wait(ctl + CW_CNT6 + 64 * T.pm, 4u, ctl + CW_TMO);
                pg8::Gemm g{(const pg8::bf16_t*)(ws + WS_R), (const pg8::bf16_t*)(ws + WS_WPG), M, DM, DM};
                pg8::EpiPle E{args.out, (const pg8::bf16_t*)(ws + WS_R), (const float*)(ws + WS_SSQ2), (const float*)args.in[I_BPG], (const pg8::bf16_t*)(ws + WS_B)};
                pg8::gemm_phase<pg8::EpiPle, pg8::TileUnit, false, true>(lds, g, T, E);
            }
        }
    } else {
    if (IN(6)) REP(6) { REPBAR();
        pg8::Gemm g{(const pg8::bf16_t*)(ws + WS_ACT), (const pg8::bf16_t*)(ws + WS_WDN), M, DM, DFF}; pg8::StaticOrder S; S.init(M, DM, G, wid);
        pg8::EpiH2 E{(const pg8::bf16_t*)(ws + WS_R), (pg8::bf16_t*)(ws + WS_R), (float*)(ws + WS_SSQ2)};
        pg8::gemm_phase<pg8::EpiH2, pg8::StaticOrder, true, true>(lds, g, S, E);
    }
    SEAM_LOCAL(6);
    if (IN(7)) REP(7) { REPBAR();
        pg8::Gemm g{(const pg8::bf16_t*)(ws + WS_R), (const pg8::bf16_t*)(ws + WS_WPG), M, DM, DM}; pg8::StaticOrder S; S.init(M, DM, G, wid);
        pg8::EpiPle E{args.out, (const pg8::bf16_t*)(ws + WS_R), (const float*)(ws + WS_SSQ2), (const float*)args.in[I_BPG], (const pg8::bf16_t*)(ws + WS_B)};
        pg8::gemm_phase<pg8::EpiPle, pg8::StaticOrder, true, true>(lds, g, S, E);
    }
    }
#undef IN
#undef SEAM
#undef SEAM_LOCAL
}

extern "C" void kernel_launch(void* const* d_in, const int* in_sizes, int n_in, void* d_out, int out_size, void* d_ws, size_t ws_size, hipStream_t stream) {
    static int grid = 0;
    if (grid == 0) {
        if (n_in != 29 || in_sizes[0] != M * DM || out_size != M * DM || ws_size < WS_END) { fprintf(stderr, "kernel_launch: unexpected shapes (n_in %d, in0 %d, out %d, ws %zu); nothing launched\n", n_in, n_in > 0 ? in_sizes[0] : -1, out_size, ws_size); grid = -1; return; }
        int dev = 0, cus = 0, per_cu = 0;
        if (hipGetDevice(&dev) != hipSuccess || hipDeviceGetAttribute(&cus, hipDeviceAttributeMultiprocessorCount, dev) != hipSuccess) { grid = -1; return; }
        if (hipFuncSetAttribute((const void*)hymba_fwd, hipFuncAttributeMaxDynamicSharedMemorySize, LDS_BYTES) != hipSuccess) { fprintf(stderr, "kernel_launch: hipFuncSetAttribute failed\n"); grid = -1; return; }
        if (hipOccupancyMaxActiveBlocksPerMultiprocessor(&per_cu, (const void*)hymba_fwd, NTHR, LDS_BYTES) != hipSuccess || per_cu < 1) { fprintf(stderr, "kernel_launch: occupancy query says %d blocks per CU\n", per_cu); per_cu = 1; }
        (void)hipGetLastError();
        grid = cus * (per_cu < 1 ? 1 : 1);
    }
    if (grid < 0) return;
    (void)hipMemsetAsync((char*)d_ws + WS_CTL, 0, CTL_ZERO_BYTES, stream);
    Args a{};
    for (int i = 0; i < 29; ++i) a.in[i] = d_in[i];
    a.out = (float*)d_out; a.ws = (unsigned char*)d_ws;
#if MK_N_LAUNCHES == 1
    a.ph_lo = 0; a.ph_hi = 8;
    void* kargs[] = {&a};
    hipError_t e = hipLaunchCooperativeKernel((const void*)hymba_fwd, dim3(grid), dim3(NTHR), kargs, LDS_BYTES, stream);
    if (e != hipSuccess) fprintf(stderr, "kernel_launch: cooperative launch failed: %s (grid %d)\n", hipGetErrorString(e), grid);
#else
    for (int ph = 0; ph < 8; ++ph) { a.ph_lo = ph; a.ph_hi = ph + 1; hipLaunchKernelGGL(hymba_fwd, dim3(grid), dim3(NTHR), LDS_BYTES, stream, a); }
#endif
}
```
